# Optimizing an MI355X kernel written in HIP

```python
import math
import jax, jax.numpy as jnp
from jax import lax
import numpy as np

D_MODEL = 1024
BATCH = 8
SEQ = 4096
DEPTH = 2

CHUNK = 64
N_A_LAYERS = DEPTH // 2
N_B_LAYERS = DEPTH - N_A_LAYERS
N_DENSE = (DEPTH + 1) // 2
N_MOE = DEPTH // 2
SSM_GROUP = 16
SSM_GROUPS = D_MODEL // SSM_GROUP
SSM_STATE = 64
DT_MIN = 1e-3
DT_MAX = 1e-1
N_HEADS = 16
QK_NOPE = 64
QK_ROPE = 32
V_HEAD = 64
Q_LORA = 512
KV_LORA = 256
ROPE_BASE = 10000.0
Q_BLOCK = 128
D_FF = 2688
N_EXPERTS = 8
TOP_K = 2
MOE_FF = 3584
EPS = 1e-6

kernel_name = "yoco_s5_mla_moe_hybrid"

F32 = jnp.float32


def rmsnorm(x, g):
    xf = x.astype(F32)
    y = xf * lax.rsqrt(jnp.mean(xf * xf, axis=-1, keepdims=True) + EPS)
    return (y * g.astype(F32)).astype(x.dtype)


def apply_rope(x, cos, sin):
    x1, x2 = jnp.split(x.astype(F32), 2, axis=-1)
    return jnp.concatenate([x1 * cos - x2 * sin, x2 * cos + x1 * sin], axis=-1).astype(x.dtype)


def swiglu(h, w_gate, w_up, w_down):
    return (jax.nn.silu(h @ w_gate) * (h @ w_up)) @ w_down


def s5_mixer(h, w_in, lam_re, lam_im, log_dt, b_re, b_im, c_re, c_im, d_skip, w_glu, w_out):
    bsz, seq, _ = h.shape
    u = (h @ w_in).astype(F32).reshape(bsz, seq, SSM_GROUPS, SSM_GROUP)
    dt = jnp.exp(log_dt.astype(F32))[:, None]
    lr, li = lam_re.astype(F32), lam_im.astype(F32)
    mag = jnp.exp(lr * dt)
    ab_re, ab_im = mag * jnp.cos(li * dt), mag * jnp.sin(li * dt)
    den = lr * lr + li * li
    nr, ni = ab_re - 1.0, ab_im
    coef_re = (nr * lr + ni * li) / den
    coef_im = (ni * lr - nr * li) / den
    br, bi = b_re.astype(F32), b_im.astype(F32)
    bb_re = coef_re[..., None] * br - coef_im[..., None] * bi
    bb_im = coef_re[..., None] * bi + coef_im[..., None] * br
    bu_re = jnp.einsum('blgn,gpn->blgp', u, bb_re)
    bu_im = jnp.einsum('blgn,gpn->blgp', u, bb_im)
    a_re = jnp.broadcast_to(ab_re[None, None], (1, seq, SSM_GROUPS, SSM_STATE))
    a_im = jnp.broadcast_to(ab_im[None, None], (1, seq, SSM_GROUPS, SSM_STATE))

    def combine(e1, e2):
        a1r, a1i, b1r, b1i = e1
        a2r, a2i, b2r, b2i = e2
        return (a2r * a1r - a2i * a1i,
                a2r * a1i + a2i * a1r,
                a2r * b1r - a2i * b1i + b2r,
                a2r * b1i + a2i * b1r + b2i)

    _, _, s_re, s_im = lax.associative_scan(combine, (a_re, a_im, bu_re, bu_im), axis=1)
    y = (jnp.einsum('blgp,gnp->blgn', s_re, c_re.astype(F32))
         - jnp.einsum('blgp,gnp->blgn', s_im, c_im.astype(F32)))
    y = y.reshape(bsz, seq, D_MODEL) + d_skip.astype(F32) * u.reshape(bsz, seq, D_MODEL)
    y = jax.nn.gelu(y).astype(h.dtype)
    z = y * jax.nn.sigmoid(y @ w_glu)
    return z @ w_out


def shared_kv(h, w_dkv, kv_latent_norm, w_ukv, cos, sin):
    bsz, seq, _ = h.shape
    ckr = h @ w_dkv
    c_kv = rmsnorm(ckr[..., :KV_LORA], kv_latent_norm)
    k_rope = apply_rope(ckr[..., KV_LORA:], cos, sin)
    kv = (c_kv @ w_ukv).reshape(bsz, seq, N_HEADS, QK_NOPE + V_HEAD)
    return kv[..., :QK_NOPE], k_rope, kv[..., QK_NOPE:]


def mla_mixer(h, k_nope, k_rope, v, w_dq, q_latent_norm, w_uq, w_o, cos, sin):
    bsz, seq, _ = h.shape
    cq = rmsnorm(h @ w_dq, q_latent_norm)
    q = (cq @ w_uq).reshape(bsz, seq, N_HEADS, QK_NOPE + QK_ROPE)
    scale = (QK_NOPE + QK_ROPE) ** -0.5
    q_nope = q[..., :QK_NOPE] * scale
    q_rope = apply_rope(q[..., QK_NOPE:], cos[:, :, None], sin[:, :, None]) * scale
    n_blk = seq // Q_BLOCK
    qn_b = q_nope.reshape(bsz, n_blk, Q_BLOCK, N_HEADS, QK_NOPE).transpose(1, 0, 2, 3, 4)
    qr_b = q_rope.reshape(bsz, n_blk, Q_BLOCK, N_HEADS, QK_ROPE).transpose(1, 0, 2, 3, 4)
    k_chunk = jnp.arange(seq) // CHUNK

    def block(args):
        i, qn, qr = args
        s = (jnp.einsum('bqhd,bkhd->bhqk', qn, k_nope, preferred_element_type=F32)
             + jnp.einsum('bqhr,bkr->bhqk', qr, k_rope, preferred_element_type=F32))
        q_chunk = (i * Q_BLOCK + jnp.arange(Q_BLOCK)) // CHUNK
        mask = k_chunk[None, :] <= q_chunk[:, None]
        p = jax.nn.softmax(jnp.where(mask, s, -jnp.inf), axis=-1)
        return jnp.einsum('bhqk,bkhd->bqhd', p.astype(v.dtype), v)

    o = lax.map(block, (jnp.arange(n_blk), qn_b, qr_b))
    o = o.transpose(1, 0, 2, 3, 4).reshape(bsz, seq, N_HEADS * V_HEAD)
    return o @ w_o


def moe_swiglu(h, router_w, w_gate, w_up, w_down):
    bsz, seq, d = h.shape
    t = h.reshape(-1, d)
    logits = (t @ router_w).astype(F32)
    top_logit, top_idx = lax.top_k(logits, TOP_K)
    top_w = jax.nn.softmax(top_logit, axis=-1)
    gates = jnp.einsum('nk,nke->ne', top_w, jax.nn.one_hot(top_idx, N_EXPERTS, dtype=F32))
    out = jnp.zeros_like(t)
    for e in range(N_EXPERTS):
        out = out + gates[:, e:e + 1].astype(t.dtype) * swiglu(t, w_gate[e], w_up[e], w_down[e])
    return out.reshape(bsz, seq, d)


def setup_inputs(seed: int = 0) -> dict:
    key = jax.random.key(seed)
    ks = iter(jax.random.split(key, 40))

    def nrm(shape, fan_in):
        return jax.random.normal(next(ks), shape, F32) * (fan_in ** -0.5)

    def gain(shape):
        return 1.0 + 0.02 * jax.random.normal(next(ks), shape, F32)

    x = jax.random.normal(next(ks), (BATCH, SEQ, D_MODEL), F32)
    offsets = jax.random.randint(next(ks), (BATCH, 1), 0, 1024, dtype=jnp.int32)
    positions = offsets + jnp.arange(SEQ, dtype=jnp.int32)[None, :]
    n_idx = jnp.arange(SSM_STATE, dtype=F32)
    gp = (N_A_LAYERS, SSM_GROUPS, SSM_STATE)
    s5_lambda_re = -0.5 + 0.01 * jax.random.normal(next(ks), gp, F32)
    s5_lambda_im = math.pi * n_idx + 0.01 * jax.random.normal(next(ks), gp, F32)
    s5_log_dt = jax.random.uniform(next(ks), (N_A_LAYERS, SSM_GROUPS), F32,
                                   math.log(DT_MIN), math.log(DT_MAX))
    bshape = (N_A_LAYERS, SSM_GROUPS, SSM_STATE, SSM_GROUP)
    cshape = (N_A_LAYERS, SSM_GROUPS, SSM_GROUP, SSM_STATE)
    return {
        "x": x,
        "positions": positions,
        "norm_mix": gain((DEPTH, D_MODEL)),
        "norm_ffn": gain((DEPTH, D_MODEL)),
        "final_norm": gain((D_MODEL,)),
        "s5_w_in": nrm((N_A_LAYERS, D_MODEL, D_MODEL), D_MODEL),
        "s5_lambda_re": s5_lambda_re,
        "s5_lambda_im": s5_lambda_im,
        "s5_log_dt": s5_log_dt,
        "s5_b_re": nrm(bshape, 2 * SSM_GROUP),
        "s5_b_im": nrm(bshape, 2 * SSM_GROUP),
        "s5_c_re": nrm(cshape, SSM_STATE),
        "s5_c_im": nrm(cshape, SSM_STATE),
        "s5_d": gain((N_A_LAYERS, D_MODEL)),
        "s5_w_glu": nrm((N_A_LAYERS, D_MODEL, D_MODEL), D_MODEL),
        "s5_w_out": nrm((N_A_LAYERS, D_MODEL, D_MODEL), D_MODEL),
        "kv_norm": gain((D_MODEL,)),
        "w_dkv": nrm((D_MODEL, KV_LORA + QK_ROPE), D_MODEL),
        "kv_latent_norm": gain((KV_LORA,)),
        "w_ukv": nrm((KV_LORA, N_HEADS * (QK_NOPE + V_HEAD)), KV_LORA),
        "w_dq": nrm((N_B_LAYERS, D_MODEL, Q_LORA), D_MODEL),
        "q_latent_norm": gain((N_B_LAYERS, Q_LORA)),
        "w_uq": nrm((N_B_LAYERS, Q_LORA, N_HEADS * (QK_NOPE + QK_ROPE)), Q_LORA),
        "w_o": nrm((N_B_LAYERS, N_HEADS * V_HEAD, D_MODEL), N_HEADS * V_HEAD),
        "ffn_w_gate": nrm((N_DENSE, D_MODEL, D_FF), D_MODEL),
        "ffn_w_up": nrm((N_DENSE, D_MODEL, D_FF), D_MODEL),
        "ffn_w_down": nrm((N_DENSE, D_FF, D_MODEL), D_FF),
        "router_w": nrm((N_MOE, D_MODEL, N_EXPERTS), D_MODEL),
        "moe_w_gate": nrm((N_MOE, N_EXPERTS, D_MODEL, MOE_FF), D_MODEL),
        "moe_w_up": nrm((N_MOE, N_EXPERTS, D_MODEL, MOE_FF), D_MODEL),
        "moe_w_down": nrm((N_MOE, N_EXPERTS, MOE_FF, D_MODEL), MOE_FF),
    }


def reference(x, positions, norm_mix, norm_ffn, final_norm, s5_w_in, s5_lambda_re, s5_lambda_im,
              s5_log_dt, s5_b_re, s5_b_im, s5_c_re, s5_c_im, s5_d, s5_w_glu, s5_w_out,
              kv_norm, w_dkv, kv_latent_norm, w_ukv, w_dq, q_latent_norm, w_uq, w_o,
              ffn_w_gate, ffn_w_up, ffn_w_down, router_w, moe_w_gate, moe_w_up, moe_w_down):
    half = QK_ROPE // 2
    inv_freq = ROPE_BASE ** (-jnp.arange(half, dtype=F32) * (2.0 / QK_ROPE))
    ang = positions.astype(F32)[..., None] * inv_freq
    cos, sin = jnp.cos(ang), jnp.sin(ang)
    kv = None
    for i in range(DEPTH):
        if i < N_A_LAYERS:
            a = i
            h = rmsnorm(x, norm_mix[i])
            x = x + s5_mixer(h, s5_w_in[a], s5_lambda_re[a], s5_lambda_im[a], s5_log_dt[a],
                             s5_b_re[a], s5_b_im[a], s5_c_re[a], s5_c_im[a], s5_d[a],
                             s5_w_glu[a], s5_w_out[a])
        else:
            if kv is None:
                kv = shared_kv(rmsnorm(x, kv_norm), w_dkv, kv_latent_norm, w_ukv, cos, sin)
            b = i - N_A_LAYERS
            k_nope, k_rope, v = kv
            h = rmsnorm(x, norm_mix[i])
            x = x + mla_mixer(h, k_nope, k_rope, v, w_dq[b], q_latent_norm[b], w_uq[b],
                              w_o[b], cos, sin)
        h = rmsnorm(x, norm_ffn[i])
        if i % 2 == 0:
            j = i // 2
            x = x + swiglu(h, ffn_w_gate[j], ffn_w_up[j], ffn_w_down[j])
        else:
            j = i // 2
            x = x + moe_swiglu(h, router_w[j], moe_w_gate[j], moe_w_up[j], moe_w_down[j])
    return rmsnorm(x, final_norm)
```

```cpp
#include <hip/hip_runtime.h>
#include <cstdio>
#include <cstdint>

#ifndef DBG_S5
#define DBG_S5 1.0f
#endif
#ifndef DBG_FFN
#define DBG_FFN 1.0f
#endif
#ifndef DBG_ATT
#define DBG_ATT 1.0f
#endif
#ifndef DBG_MOE
#define DBG_MOE 1.0f
#endif
#ifndef DBG_DIAG
#define DBG_DIAG 0
#endif
#ifndef PROBE_MODE
#define PROBE_MODE 1
#endif
#ifndef MK_ONE_LAUNCH
#define MK_ONE_LAUNCH 1
#endif

#define GAS __attribute__((address_space(1)))
#define LAS __attribute__((address_space(3)))
typedef unsigned short bf16;
typedef short bf16x8 __attribute__((ext_vector_type(8)));
typedef short s16x4 __attribute__((ext_vector_type(4)));
typedef float f32x2 __attribute__((ext_vector_type(2)));
typedef float f32x4 __attribute__((ext_vector_type(4)));
typedef float f32x16 __attribute__((ext_vector_type(16)));
typedef unsigned u32x2 __attribute__((ext_vector_type(2)));
typedef unsigned u32x4 __attribute__((ext_vector_type(4)));
typedef GAS unsigned gu32;

constexpr int BATCH = 8, SEQ = 4096, DM = 1024, M = BATCH * SEQ;
constexpr int SG = 64, SGC = 16, SP = 64;
constexpr int TCH = 32, NCH = SEQ / TCH, BC = BATCH * NCH;
constexpr int UK = TCH * SGC, UGLD = UK + 2 * SP;
constexpr int DFF = 2688, NGU = 2 * DFF;
constexpr int NH = 16, DNOPE = 64, DROPE = 32, DV = 64, QL = 512, KVL = 256;
constexpr int NE = 8, MFF = 3584, NMGU = 2 * MFF;
constexpr int MAXPANEL = 264;
constexpr int SLICE_P = 256, NSLICE = 2;
constexpr float FS_A = 16.f, FS_W = 64.f, FS_H = 8.f;
constexpr float EPS = 1e-6f;
constexpr float QSCALE = 0.10206207261596575f * 1.4426950408889634f;

constexpr size_t MiB = 1u << 20;
constexpr size_t WS_CTL = 0, CTL_ZERO_BYTES = 1 * MiB;
constexpr size_t WS_ST = 1 * MiB;
constexpr size_t WS_STKV = 3 * MiB;
constexpr size_t WS_STQ = 3 * MiB + 512 * 1024;
constexpr size_t WS_COS = 5 * MiB, WS_SIN = 7 * MiB;
constexpr size_t WS_TOK = 9 * MiB;
constexpr size_t WS_POS = 9 * MiB + 512 * 1024;
constexpr size_t WS_CNT = 9 * MiB + 768 * 1024;
constexpr size_t WS_MINFO = 9 * MiB + 896 * 1024;
constexpr size_t WS_ROUTW = 10 * MiB;
constexpr size_t WS_A32 = 10 * MiB + 64 * 1024;
constexpr size_t WS_KR = 11 * MiB;
constexpr size_t WS_WIN = 16 * MiB, WS_WGLU = 18 * MiB, WS_WOUT = 20 * MiB, WS_WGU = 22 * MiB, WS_WDOWN = 33 * MiB, WS_WKVQ = 39 * MiB, WS_WUKV = 41 * MiB, WS_WUQ = 42 * MiB, WS_WO = 44 * MiB;
constexpr size_t WS_ARENA = 48 * MiB;
constexpr size_t WS_BT4 = WS_ARENA;
constexpr size_t WS_WEND = WS_ARENA + 40 * MiB;
constexpr size_t WS_UG = WS_ARENA + 56 * MiB;
constexpr size_t WS_E = WS_ARENA + 136 * MiB;
constexpr size_t WS_YB = WS_ARENA + 168 * MiB;
constexpr size_t WS_ZB = WS_ARENA + 232 * MiB;
constexpr size_t WS_HB = WS_ARENA;
constexpr size_t WS_KN = WS_ARENA + 84 * MiB;
constexpr size_t WS_VB = WS_ARENA + 148 * MiB;
constexpr size_t WS_QN = WS_ARENA + 212 * MiB;
constexpr size_t WS_QR = WS_ARENA + 276 * MiB;
constexpr size_t WS_CKV = WS_ARENA + 308 * MiB;
constexpr size_t WS_CQ = WS_ARENA + 324 * MiB;
constexpr size_t OUT_WMGU = 0;
constexpr size_t WS_SLAB = WS_ARENA + 364 * MiB;
constexpr size_t OUT_WMDN = 56 * MiB;
constexpr size_t WS_HS = WS_ARENA;
constexpr size_t WS_YS = WS_ARENA;
constexpr size_t WS_ACT = WS_ARENA + 132 * MiB;
constexpr size_t WS_XB = 448 * MiB;
constexpr size_t WS_END = 512 * MiB;
static_assert(WS_ACT + (size_t)MAXPANEL * 256 * MFF <= WS_SLAB && WS_YS + (size_t)MAXPANEL * 256 * DM * 2 <= WS_ACT && WS_SLAB + (size_t)7 * 2048 * DM * 2 <= WS_XB && OUT_WMDN + (size_t)NE * DM * MFF <= (size_t)M * DM * 4 && WS_CQ + (size_t)M * 512 * 2 <= WS_XB && WS_ZB + (size_t)M * DM * 2 <= WS_XB, "ws map");
constexpr int CW_TMO = 0, CW_BAR = 4096;

__device__ __forceinline__ unsigned cvt_pk_bf16(float lo, float hi) { unsigned r; asm volatile("v_cvt_pk_bf16_f32 %0, %1, %2" : "=v"(r) : "v"(lo), "v"(hi)); return r; }
__device__ __forceinline__ float bf2f(unsigned short b) { return __builtin_bit_cast(float, (unsigned)b << 16); }
__device__ __forceinline__ float u2f(unsigned u) { return __builtin_bit_cast(float, u); }
__device__ __forceinline__ float bflo(unsigned w) { return __builtin_bit_cast(float, w << 16); }
__device__ __forceinline__ float bfhi(unsigned w) { return __builtin_bit_cast(float, w & 0xffff0000u); }
__device__ __forceinline__ u32x4 pack8(f32x4 a, f32x4 b) { u32x4 w; w.x = cvt_pk_bf16(a[0], a[1]); w.y = cvt_pk_bf16(a[2], a[3]); w.z = cvt_pk_bf16(b[0], b[1]); w.w = cvt_pk_bf16(b[2], b[3]); return w; }
__device__ __forceinline__ unsigned pack4_fp8(f32x4 v) {
    int w = 0; w = __builtin_amdgcn_cvt_pk_fp8_f32(__builtin_amdgcn_fmed3f(v[0], -448.f, 448.f), __builtin_amdgcn_fmed3f(v[1], -448.f, 448.f), w, false);
    w = __builtin_amdgcn_cvt_pk_fp8_f32(__builtin_amdgcn_fmed3f(v[2], -448.f, 448.f), __builtin_amdgcn_fmed3f(v[3], -448.f, 448.f), w, true); return (unsigned)w;
}
__device__ __forceinline__ float fast_exp2(float x) { return __builtin_amdgcn_exp2f(x); }
__device__ __forceinline__ float fast_rcp(float x) { return __builtin_amdgcn_rcpf(x); }
__device__ __forceinline__ float sigmoid_f(float x) { return fast_rcp(1.0f + fast_exp2(-1.4426950408889634f * x)); }
__device__ __forceinline__ float silu_f(float x) { return x * sigmoid_f(x); }
__device__ __forceinline__ float gelu_tanh_f(float x) { const float z = 0.7978845608028654f * (x + 0.044715f * x * x * x); return x * sigmoid_f(2.0f * z); }
__device__ __forceinline__ float wave_sum(float v) {
#pragma unroll
    for (int o = 1; o < 64; o <<= 1) v += __shfl_xor(v, o);
    return v;
}
#define LDS_WAIT() asm volatile("s_waitcnt lgkmcnt(0)" ::: "memory")
#define VM_WAIT() asm volatile("s_waitcnt vmcnt(0)" ::: "memory")

namespace pg8 {
constexpr int BM = 256, BK = 64, HALF = 128, HTB = HALF * BK * 2, STAGE_BYTES = 8 * HTB;
__host__ __device__ __forceinline__ int lds_byte(int r, int c) { const int st = (r >> 4) * 2 + (c >> 5), rr = r & 15, cc = c & 31, ob = rr * 64 + cc * 2; return st * 1024 + (ob ^ (((ob >> 9) & 1) << 5)); }
__host__ __device__ __forceinline__ void stage_rc(int b, int& R, int& C) { const int st = b / 1024, sb = b % 1024, swz = sb ^ (((sb >> 9) & 1) << 5); R = (st >> 1) * 16 + swz / 64; C = (st & 1) * 32 + (swz % 64) / 2; }
__host__ __device__ __forceinline__ int perm32(int rho) { const int n = rho >> 4, i = rho & 15; return 8 * (i >> 2) + 4 * n + (i & 3); }

struct Unit { int pm, pn, z, ord; int offA, offB; };
struct Gemm { const bf16* A; const bf16* Bt; int lda, ldb, K; size_t zA, zB; };

struct Order2D {
    int nM, nN, nwg, G, c;
    __device__ void init(int nM_, int nN_, int G_, int c_) { nM = nM_; nN = nN_; nwg = nM * nN; G = G_; c = c_; }
    __device__ bool next(int i, Unit& u) const {
        const long L = (long)i * G + c; if (L >= nwg) return false;
        int wgid = (int)L; { const int q = nwg / 8, r = nwg % 8, xcd = wgid % 8, off = wgid / 8; wgid = (xcd < r ? xcd * (q + 1) : r * (q + 1) + (xcd - r) * q) + off; }
        const int nig = 8 * nN, gid = wgid / nig, fm = gid * 8, gsz = (nM - fm) < 8 ? (nM - fm) : 8;
        u.pm = fm + ((wgid % nig) % gsz); u.pn = (wgid % nig) / gsz; u.z = 0; u.ord = i; u.offA = 0; u.offB = 0; return true;
    }
    __device__ __forceinline__ void unit_sync() const {}
};
struct OrderBatch {
    int nM, nN, nZ, G, c;
    __device__ void init(int nM_, int nN_, int nZ_, int G_, int c_) { nM = nM_; nN = nN_; nZ = nZ_; G = G_; c = c_; }
    __device__ bool next(int i, Unit& u) const {
        const long L = (long)i * G + c; const int per = nM * nN; if (L >= (long)per * nZ) return false;
        const int z = (int)(L / per), r = (int)(L % per); u.z = z; u.pm = r / nN; u.pn = r % nN; u.ord = i; u.offA = 0; u.offB = 0; return true;
    }
    __device__ __forceinline__ void unit_sync() const {}
};
struct OrderMoe {
    const int* pexp; int p0, np, nN, G, c, flat;
    __device__ void init(const int* pexp_, int p0_, int p1_, int nN_, int G_, int c_, int flat_ = 0) { pexp = pexp_; p0 = p0_; np = p1_ > p0_ ? p1_ - p0_ : 0; nN = nN_; G = G_; c = c_; flat = flat_; gb_bar = nullptr; gb_x = 0; gb_st = nullptr; }
    __device__ bool next(int i, Unit& u) const {
        const long L = (long)i * G + c; if (L >= (long)np * nN) return false;
        const int l = (int)L, nig = 8 * nN, gid = l / nig, fm = gid * 8, gsz = (np - fm) < 8 ? (np - fm) : 8;
        u.pm = p0 + fm + ((l % nig) % gsz); u.pn = (l % nig) / gsz; if (flat == 1) { u.pm = p0 + (c & 7); u.pn = (c >> 3) & 3; } else if (flat == 2) { u.pm = p0; u.pn = 0; } else if (flat == 3) { u.pm = p0 + (c & 1); u.pn = (c >> 1) & 1; } else if (flat == 4) { u.pm = p0 + ((u.pm - p0) & 63); } u.z = pexp[u.pm]; u.ord = i; u.offA = 0; u.offB = 0; return true;
    }
    unsigned* gb_bar; unsigned gb_x; volatile LAS unsigned* gb_st;
    __device__ __forceinline__ void unit_sync() const;
};

struct OrderPanel {
    int z, pm, nN;
    __device__ bool next(int i, Unit& u) const { if (i >= nN) return false; u.pm = pm; u.pn = i; u.z = z; u.ord = i; u.offA = 0; u.offB = 0; return true; }
    __device__ __forceinline__ void unit_sync() const {}
};
constexpr int KSPLIT = 7;
struct OrderMoeSplit {
    const int* pexp; int p0, np, G, c;
    __device__ void init(const int* pexp_, int p0_, int p1_, int G_, int c_) { pexp = pexp_; p0 = p0_; np = p1_ > p0_ ? p1_ - p0_ : 0; G = G_; c = c_; }
    __device__ bool next(int i, Unit& u) const {
        const long L = (long)i * G + c; if (L >= (long)np * 4 * KSPLIT) return false;
        const int l = (int)L, kq = l % KSPLIT, r = l / KSPLIT; u.pn = r & 3; u.pm = p0 + (r >> 2); u.z = pexp[u.pm]; u.ord = kq; u.offA = kq * 512; u.offB = kq * 512; return true;
    }
    __device__ __forceinline__ void unit_sync() const {}
};
typedef int v8i __attribute__((ext_vector_type(8)));
typedef int v4i __attribute__((ext_vector_type(4)));
template <class Epi, class Sched, bool FP8 = false>
__device__ __forceinline__ void gemm_phase(LAS unsigned char* lds, const Gemm g, const Sched& S, const Epi& E) {
    int tid_ = threadIdx.x; asm volatile("" : "+v"(tid_));
    const int tid = tid_, wid = __builtin_amdgcn_readfirstlane(tid >> 6), lane = tid & 63, wr = wid >> 2, wc = wid & 3, fr = lane & 15, fq = lane >> 4;
    int K_ = g.K; asm volatile("" : "+s"(K_));
    const int K = K_, nt = K / BK;
    unsigned voffA[2], voffB[2];
#pragma unroll
    for (int i = 0; i < 2; ++i) { int R, C; stage_rc(tid * 16 + i * 8192, R, C); const int Rb = (R & ~31) + perm32(R & 31);
        voffA[i] = (unsigned)(R * g.lda + C) * 2u; voffB[i] = (unsigned)(Rb * g.ldb + C) * 2u; }
    const size_t kstep = (size_t)(BK * 2);
    const size_t hstepA = (size_t)HALF * g.lda * 2, hstepB = (size_t)HALF * g.ldb * 2;
    const unsigned ldsw = (unsigned)wid * 1024u;
    const int aoff = FP8 ? lds_byte(wr * 64 + fr, fq * 16) : lds_byte(wr * 64 + fr, fq * 8), boff = FP8 ? lds_byte(wc * 32 + fr, fq * 16) : lds_byte(wc * 32 + fr, fq * 8);
    const int aoff2 = lds_byte(wr * 64 + fr, fq * 16 + 8), boff2 = lds_byte(wc * 32 + fr, fq * 16 + 8);
#define PG8_SA(b, h) (((b) * 2 + (h)) * HTB)
#define PG8_SB(b, h) ((4 + (b) * 2 + (h)) * HTB)
#define PG8_STAGE(bufoff, gbase, voff) do { _Pragma("unroll") for (int _i = 0; _i < 2; ++_i) \
        __builtin_amdgcn_global_load_lds((const unsigned*)((const char*)(gbase) + (voff)[_i]), (LAS unsigned*)(lds + (bufoff) + ldsw + _i * 8192), 16, 0, 0); } while (0)
#define PG8_LD8(p1, p2) __builtin_shufflevector(*(const LAS v4i*)(p1), *(const LAS v4i*)(p2), 0, 1, 2, 3, 4, 5, 6, 7)
#define PG8_LDA8(dst, b, h) do { _Pragma("unroll") for (int m = 0; m < 4; ++m) dst##8[m] = PG8_LD8(lds + PG8_SA(b, h) + aoff + m * 2048, lds + PG8_SA(b, h) + aoff2 + m * 2048); } while (0)
#define PG8_LDB8(dst, b, h) do { _Pragma("unroll") for (int n = 0; n < 2; ++n) dst##8[n] = PG8_LD8(lds + PG8_SB(b, h) + boff + n * 2048, lds + PG8_SB(b, h) + boff2 + n * 2048); } while (0)
#define PG8_LDA(dst, b, h) do { if constexpr (FP8) { PG8_LDA8(dst, b, h); } else { _Pragma("unroll") for (int m = 0; m < 4; ++m) _Pragma("unroll") for (int k = 0; k < 2; ++k) dst[m][k] = *(const LAS bf16x8*)(lds + PG8_SA(b, h) + aoff + m * 2048 + k * 1024); } } while (0)
#define PG8_LDB(dst, b, h) do { if constexpr (FP8) { PG8_LDB8(dst, b, h); } else { _Pragma("unroll") for (int n = 0; n < 2; ++n) _Pragma("unroll") for (int k = 0; k < 2; ++k) dst[n][k] = *(const LAS bf16x8*)(lds + PG8_SB(b, h) + boff + n * 2048 + k * 1024); } } while (0)
#define PG8_V8(x) __builtin_bit_cast(v8i, (x))
#define PG8_MMA(ai, bj, At, Bt) do { __builtin_amdgcn_s_setprio(1); if constexpr (FP8) { _Pragma("unroll") for (int m = 0; m < 4; ++m) _Pragma("unroll") for (int n = 0; n < 2; ++n) \
        asm volatile("v_mfma_scale_f32_16x16x128_f8f6f4 %0, %1, %2, %0, %3, %3 op_sel_hi:[0,0,0]" : "+v"(acc[ai][bj][m][n]) : "v"(Bt##8[n]), "v"(At##8[m]), "v"(fscale)); } else { \
        _Pragma("unroll") for (int m = 0; m < 4; ++m) _Pragma("unroll") for (int n = 0; n < 2; ++n) _Pragma("unroll") for (int k = 0; k < 2; ++k) \
        acc[ai][bj][m][n] = __builtin_amdgcn_mfma_f32_16x16x32_bf16(Bt[n][k], At[m][k], acc[ai][bj][m][n], 0, 0, 0); } __builtin_amdgcn_s_setprio(0); } while (0)
#define PG8_WAIT_V(n) asm volatile("s_waitcnt vmcnt(" #n ")" ::: "memory")
#define PG8_WAIT_L(n) asm volatile("s_waitcnt lgkmcnt(" #n ")" ::: "memory")
#define PG8_BAR __builtin_amdgcn_s_barrier()
#define PG8_SCHED __builtin_amdgcn_sched_barrier(0)
    Unit cur, nxt; int ui = 0;
    if (!S.next(0, cur)) return;
    f32x4 acc[2][2][4][2];
#pragma unroll
    for (int a = 0; a < 2; ++a)
#pragma unroll
        for (int b = 0; b < 2; ++b)
#pragma unroll
            for (int m = 0; m < 4; ++m)
#pragma unroll
                for (int n = 0; n < 2; ++n) acc[a][b][m][n] = (f32x4){0.f, 0.f, 0.f, 0.f};
    bf16x8 At[FP8 ? 1 : 4][2], B0[FP8 ? 1 : 2][2], B1[FP8 ? 1 : 2][2];
    v8i At8[FP8 ? 4 : 1], B08[FP8 ? 2 : 1], B18[FP8 ? 2 : 1];
    int fscale = 0; if constexpr (FP8) { fscale = 0x7f7f7f7f; asm volatile("" : "+v"(fscale)); }
    const char* cA = (const char*)g.A + (size_t)cur.z * g.zA + (size_t)cur.pm * 2 * hstepA + cur.offA; const char* cB = (const char*)g.Bt + (size_t)cur.z * g.zB + (size_t)cur.pn * 2 * hstepB + cur.offB;
    PG8_STAGE(PG8_SB(0, 0), cB, voffB); PG8_STAGE(PG8_SB(0, 1), cB + hstepB, voffB); PG8_STAGE(PG8_SA(0, 0), cA, voffA); PG8_STAGE(PG8_SA(0, 1), cA + hstepA, voffA);
    if (wr == 1) PG8_BAR;
    PG8_WAIT_V(2); PG8_BAR;
    PG8_STAGE(PG8_SB(1, 0), cB + kstep, voffB); PG8_STAGE(PG8_SA(1, 0), cA + kstep, voffA); PG8_STAGE(PG8_SB(1, 1), cB + hstepB + kstep, voffB);
    PG8_WAIT_V(6); PG8_BAR;
    for (;;) {
        const bool has_next = S.next(ui + 1, nxt);
        const char* nA = has_next ? (const char*)g.A + (size_t)nxt.z * g.zA + (size_t)nxt.pm * 2 * hstepA + nxt.offA : cA; const char* nB = has_next ? (const char*)g.Bt + (size_t)nxt.z * g.zB + (size_t)nxt.pn * 2 * hstepB + nxt.offB : cB;
#pragma unroll 1
        for (int t = 0; t < nt; t += 2) {
            const bool last = (t == nt - 2);
            const char* a1 = cA + (size_t)(t + 1) * kstep;
            const char* a2 = last ? nA : cA + (size_t)(t + 2) * kstep; const char* b2 = last ? nB : cB + (size_t)(t + 2) * kstep;
            const char* a3 = a2 + kstep; const char* b3 = b2 + kstep;
            PG8_LDB(B0, 0, 0); PG8_LDB(B1, 0, 1); PG8_SCHED; PG8_LDA(At, 0, 0); PG8_STAGE(PG8_SA(1, 1), a1 + hstepA, voffA);
            PG8_WAIT_V(8); PG8_WAIT_L(0); PG8_BAR; PG8_MMA(0, 0, At, B0); PG8_MMA(0, 1, At, B1); PG8_BAR; PG8_SCHED;
            PG8_LDA(At, 0, 1); PG8_STAGE(PG8_SB(0, 0), b2, voffB); PG8_STAGE(PG8_SB(0, 1), b2 + hstepB, voffB); PG8_STAGE(PG8_SA(0, 0), a2, voffA);
            PG8_WAIT_V(8); PG8_WAIT_L(0); PG8_BAR; PG8_MMA(1, 0, At, B0); PG8_MMA(1, 1, At, B1); PG8_BAR; PG8_SCHED;
            PG8_LDB(B0, 1, 0); PG8_LDB(B1, 1, 1); PG8_SCHED; PG8_LDA(At, 1, 0); PG8_STAGE(PG8_SA(0, 1), a2 + hstepA, voffA);
            PG8_WAIT_V(8); PG8_WAIT_L(0); PG8_BAR; PG8_MMA(0, 0, At, B0); PG8_MMA(0, 1, At, B1); PG8_BAR; PG8_SCHED;
            PG8_LDA(At, 1, 1); PG8_STAGE(PG8_SB(1, 0), b3, voffB); PG8_STAGE(PG8_SB(1, 1), b3 + hstepB, voffB); PG8_STAGE(PG8_SA(1, 0), a3, voffA);
            PG8_WAIT_V(8); PG8_WAIT_L(0); PG8_BAR; PG8_MMA(1, 0, At, B0); PG8_MMA(1, 1, At, B1); PG8_BAR; PG8_SCHED;
        }
        if (wr == 0) PG8_BAR;
        if constexpr (FP8) asm volatile("s_nop 15\n\ts_nop 15" ::: "memory");
        { int el = threadIdx.x; asm volatile("" : "+v"(el));
          E(acc, cur, wr, wc, el & 15, (el >> 4) & 3); }
        S.unit_sync();
        if (!has_next) break;
#pragma unroll
        for (int a = 0; a < 2; ++a)
#pragma unroll
            for (int b = 0; b < 2; ++b)
#pragma unroll
                for (int m = 0; m < 4; ++m)
#pragma unroll
                    for (int n = 0; n < 2; ++n) acc[a][b][m][n] = (f32x4){0.f, 0.f, 0.f, 0.f};
        cur = nxt; cA = nA; cB = nB; ++ui;
        if (wr == 1) PG8_BAR;
    }
    PG8_WAIT_V(0);
    PG8_BAR;
#undef PG8_SA
#undef PG8_SB
#undef PG8_STAGE
#undef PG8_LDA
#undef PG8_LDB
#undef PG8_MMA
#undef PG8_V8
#undef PG8_LDA8
#undef PG8_LDB8
#undef PG8_LD8
#undef PG8_WAIT_V
#undef PG8_WAIT_L
#undef PG8_BAR
#undef PG8_SCHED
}

typedef const f32x4 (&Acc)[2][2][4][2];
#define EPI_ARGS Acc acc, const Unit& u, int wr, int wc, int fr, int fq
#define FOR_ROWS _Pragma("unroll") for (int ai = 0; ai < 2; ++ai) _Pragma("unroll") for (int m = 0; m < 4; ++m)
#define ROW_OF (u.pm * 256 + ai * 128 + wr * 64 + m * 16 + fr)

constexpr int RSL_OFF = 131072, RSL_MAX_UNITS = 15;
template <int NP, class Sched> __device__ __forceinline__ void build_rs_table(LAS unsigned char* lds, const float* st, const Sched& S, float invC) {
    LAS float* RSL = (LAS float*)(lds + RSL_OFF); const int t = threadIdx.x, r = t & 255;
    for (int i = t >> 8; i < RSL_MAX_UNITS; i += 2) { Unit u; if (!S.next(i, u)) break; const size_t row = (size_t)u.pm * 256 + r; float s = 0.f;
#pragma unroll
        for (int q = 0; q < NP / 4; ++q) { const f32x4 v = *(const f32x4*)(st + row * NP + 4 * q); s += (v[0] + v[1]) + (v[2] + v[3]); }
        RSL[i * 256 + r] = rsqrtf(s * invC + EPS); }
    __syncthreads();
}
__device__ __forceinline__ const LAS float* rs_base(LAS unsigned char* lds, const Unit& u, int wr, int fr) { int o = (u.ord * 256 + wr * 64 + fr) * 4 + RSL_OFF; asm volatile("" : "+v"(o)); return (const LAS float*)(lds + o); }
#define RS_OF(lds) (rsb[ai * 128 + m * 16])
__device__ __forceinline__ float sumsq8(f32x4 a, f32x4 b) { return (a[0] * a[0] + a[1] * a[1]) + (a[2] * a[2] + a[3] * a[3]) + (b[0] * b[0] + b[1] * b[1]) + (b[2] * b[2] + b[3] * b[3]); }

struct EpiUin { LAS unsigned char* lds; bf16* UG;
    __device__ __forceinline__ void operator()(EPI_ARGS) const {
        const LAS float* rsb = rs_base(lds, u, wr, fr);
        FOR_ROWS { const int row = ROW_OF; const float rs = RS_OF(lds);
            const int b = row >> 12, t = row & 4095, c = t >> 5, j = t & 31;
#pragma unroll
            for (int bj = 0; bj < 2; ++bj) { const int col0 = u.pn * 256 + bj * 128 + wc * 32 + 8 * fq, gg = col0 >> 4, m0 = col0 & 15;
                *(u32x4*)(UG + ((size_t)(gg * BC + b * NCH + c)) * UGLD + j * 16 + m0) = pack8(acc[ai][bj][m][0] * rs, acc[ai][bj][m][1] * rs); } }
    }
};
struct EpiEnd { float* E;
    __device__ __forceinline__ void operator()(EPI_ARGS) const {
        FOR_ROWS { const int row = ROW_OF; float* p = E + ((size_t)u.z * BC + row) * 128 + wc * 32 + 8 * fq;
            *(f32x4*)p = acc[ai][0][m][0]; *(f32x4*)(p + 4) = acc[ai][0][m][1]; }
    }
};
struct EpiS5Y { bf16* YB;
    __device__ __forceinline__ void operator()(EPI_ARGS) const {
        FOR_ROWS { const int row = ROW_OF; const int b = row >> 7, c = row & 127;
#pragma unroll
            for (int bj = 0; bj < 2; ++bj) { const int col0 = u.pn * 256 + bj * 128 + wc * 32 + 8 * fq, i = col0 >> 4, n0 = col0 & 15;
                f32x4 v0 = acc[ai][bj][m][0], v1 = acc[ai][bj][m][1];
#pragma unroll
                for (int e = 0; e < 4; ++e) { v0[e] = gelu_tanh_f(v0[e]); v1[e] = gelu_tanh_f(v1[e]); }
                *(u32x4*)(YB + ((size_t)(b * SEQ + c * TCH + i)) * DM + u.z * 16 + n0) = pack8(v0, v1); } }
    }
};
struct EpiGlu { const bf16* YB; bf16* ZB;
    __device__ __forceinline__ void operator()(EPI_ARGS) const {
        u32x4 y[2][4][2];
        FOR_ROWS { const int row = ROW_OF;
#pragma unroll
            for (int bj = 0; bj < 2; ++bj) y[ai][m][bj] = *(const u32x4*)(YB + (size_t)row * DM + u.pn * 256 + bj * 128 + wc * 32 + 8 * fq); }
        FOR_ROWS { const int row = ROW_OF;
#pragma unroll
            for (int bj = 0; bj < 2; ++bj) { const int col0 = u.pn * 256 + bj * 128 + wc * 32 + 8 * fq; const size_t o = (size_t)row * DM + col0;
                const u32x4 yy = y[ai][m][bj]; f32x4 v0 = acc[ai][bj][m][0], v1 = acc[ai][bj][m][1];
                v0[0] = bflo(yy.x) * sigmoid_f(v0[0]); v0[1] = bfhi(yy.x) * sigmoid_f(v0[1]); v0[2] = bflo(yy.y) * sigmoid_f(v0[2]); v0[3] = bfhi(yy.y) * sigmoid_f(v0[3]);
                v1[0] = bflo(yy.z) * sigmoid_f(v1[0]); v1[1] = bfhi(yy.z) * sigmoid_f(v1[1]); v1[2] = bflo(yy.w) * sigmoid_f(v1[2]); v1[3] = bfhi(yy.w) * sigmoid_f(v1[3]);
                *(u32x4*)(ZB + o) = pack8(v0, v1); } }
    }
};
template <int MODE> struct EpiResid { const float* xin; float* XF; bf16* XB; float* st; float bs;
    __device__ __forceinline__ void operator()(EPI_ARGS) const {
#pragma unroll
        for (int ai = 0; ai < 2; ++ai) {
            f32x4 x[4][2][2];
#pragma unroll
            for (int m = 0; m < 4; ++m) { const int row = ROW_OF;
#pragma unroll
                for (int bj = 0; bj < 2; ++bj) { const size_t o = (size_t)row * DM + u.pn * 256 + bj * 128 + wc * 32 + 8 * fq;
                    if (MODE == 0) { x[m][bj][0] = *(const f32x4*)(xin + o); x[m][bj][1] = *(const f32x4*)(xin + o + 4); }
                    else { const u32x4 w = *(const u32x4*)(XB + o); x[m][bj][0] = (f32x4){bflo(w.x), bfhi(w.x), bflo(w.y), bfhi(w.y)}; x[m][bj][1] = (f32x4){bflo(w.z), bfhi(w.z), bflo(w.w), bfhi(w.w)}; } } }
#pragma unroll
            for (int m = 0; m < 4; ++m) { const int row = ROW_OF; float ss = 0.f;
#pragma unroll
                for (int bj = 0; bj < 2; ++bj) { const size_t o = (size_t)row * DM + u.pn * 256 + bj * 128 + wc * 32 + 8 * fq;
                    const f32x4 v0 = x[m][bj][0] + acc[ai][bj][m][0] * bs, v1 = x[m][bj][1] + acc[ai][bj][m][1] * bs;
                    if (MODE == 2) { *(f32x4*)(XF + o) = v0; *(f32x4*)(XF + o + 4) = v1; }
                    else { *(u32x4*)(XB + o) = pack8(v0, v1); if (MODE != 3) ss += sumsq8(v0, v1); } }
                if (MODE != 2 && MODE != 3) { ss += __shfl_xor(ss, 16); ss += __shfl_xor(ss, 32); if (fq == 0) st[(size_t)row * 16 + u.pn * 4 + wc] = ss; } }
        }
    }
};
struct EpiSwiglu { LAS unsigned char* lds; bf16* H; int ldh; int row_sub; int use_rs; int mode;
    __device__ __forceinline__ void operator()(EPI_ARGS) const {
        const LAS float* rsb = use_rs ? rs_base(lds, u, wr, fr) : (const LAS float*)lds;
        if (mode == 3) return;
        FOR_ROWS { const int row = ROW_OF; const float rs = use_rs ? RS_OF(lds) : 1.0f;
            f32x4 g0 = acc[ai][0][m][0] * rs, g1 = acc[ai][0][m][1] * rs; const f32x4 u0 = acc[ai][1][m][0] * rs, u1 = acc[ai][1][m][1] * rs;
#pragma unroll
            for (int e = 0; e < 4; ++e) { if (mode == 2) { g0[e] = g0[e] + u0[e]; g1[e] = g1[e] + u1[e]; } else { g0[e] = silu_f(g0[e]) * u0[e]; g1[e] = silu_f(g1[e]) * u1[e]; } }
            *(u32x4*)(H + (size_t)(row - row_sub) * ldh + u.pn * 128 + wc * 32 + 8 * fq) = pack8(g0, g1); }
    }
};
struct RopeTab { f32x4 cA, cB, sA, sB; };
__device__ __forceinline__ RopeTab rope_load(const float* cosb, const float* sinb, int row, int fq) {
    const int c0 = (8 * fq) & 15; RopeTab t; t.cA = *(const f32x4*)(cosb + (size_t)row * 16 + c0); t.cB = *(const f32x4*)(cosb + (size_t)row * 16 + c0 + 4);
    t.sA = *(const f32x4*)(sinb + (size_t)row * 16 + c0); t.sB = *(const f32x4*)(sinb + (size_t)row * 16 + c0 + 4); return t;
}
__device__ __forceinline__ void rope8(f32x4& v0, f32x4& v1, const RopeTab& t, int fq) {
    f32x4 p0, p1;
#pragma unroll
    for (int e = 0; e < 4; ++e) { p0[e] = __shfl_xor(v0[e], 32); p1[e] = __shfl_xor(v1[e], 32); }
    if (fq < 2) { v0 = v0 * t.cA - p0 * t.sA; v1 = v1 * t.cB - p1 * t.sB; }
    else        { v0 = v0 * t.cA + p0 * t.sA; v1 = v1 * t.cB + p1 * t.sB; }
}
struct EpiKvq { LAS unsigned char* lds; bf16* CKV; bf16* CQ; bf16* KR; float* stkv; float* stq; const float* cosb; const float* sinb;
    __device__ __forceinline__ void operator()(EPI_ARGS) const {
        const LAS float* rsb = rs_base(lds, u, wr, fr);
        if (u.pn == 3) {
            if (wc == 0) {
#pragma unroll
                for (int ai = 0; ai < 2; ++ai) { RopeTab t[4];
#pragma unroll
                    for (int m = 0; m < 4; ++m) t[m] = rope_load(cosb, sinb, ROW_OF, fq);
#pragma unroll
                    for (int m = 0; m < 4; ++m) { const int row = ROW_OF; const float rs = RS_OF(lds); f32x4 v0 = acc[ai][0][m][0] * rs, v1 = acc[ai][0][m][1] * rs;
                        rope8(v0, v1, t[m], fq); *(u32x4*)(KR + (size_t)row * 32 + 8 * fq) = pack8(v0, v1); } }
            }
            return;
        }
        FOR_ROWS { const int row = ROW_OF; const float rs = RS_OF(lds); float ss = 0.f;
#pragma unroll
            for (int bj = 0; bj < 2; ++bj) { const int cl = bj * 128 + wc * 32 + 8 * fq; const f32x4 v0 = acc[ai][bj][m][0] * rs, v1 = acc[ai][bj][m][1] * rs; ss += sumsq8(v0, v1);
                if (u.pn == 0) *(u32x4*)(CKV + (size_t)row * KVL + cl) = pack8(v0, v1); else *(u32x4*)(CQ + (size_t)row * QL + (u.pn - 1) * 256 + cl) = pack8(v0, v1); }
            ss += __shfl_xor(ss, 16); ss += __shfl_xor(ss, 32);
            if (fq == 0) { if (u.pn == 0) stkv[(size_t)row * 4 + wc] = ss; else stq[(size_t)row * 8 + (u.pn - 1) * 4 + wc] = ss; } }
    }
};
struct EpiUkv { LAS unsigned char* lds; bf16* KN; bf16* VB;
    __device__ __forceinline__ void operator()(EPI_ARGS) const {
        bf16* dst = u.pn < 4 ? KN : VB; const int ct = (u.pn & 3) * 256; const LAS float* rsb = rs_base(lds, u, wr, fr);
        FOR_ROWS { const int row = ROW_OF; const float rs = RS_OF(lds);
#pragma unroll
            for (int bj = 0; bj < 2; ++bj) *(u32x4*)(dst + (size_t)row * DM + ct + bj * 128 + wc * 32 + 8 * fq) = pack8(acc[ai][bj][m][0] * rs, acc[ai][bj][m][1] * rs); }
    }
};
struct EpiUq { LAS unsigned char* lds; bf16* QN; bf16* QR; const float* cosb; const float* sinb;
    __device__ __forceinline__ void operator()(EPI_ARGS) const {
        const LAS float* rsb = rs_base(lds, u, wr, fr);
        if (u.pn < 4) {
            FOR_ROWS { const int row = ROW_OF; const float rs = RS_OF(lds) * QSCALE;
#pragma unroll
                for (int bj = 0; bj < 2; ++bj) *(u32x4*)(QN + (size_t)row * DM + u.pn * 256 + bj * 128 + wc * 32 + 8 * fq) = pack8(acc[ai][bj][m][0] * rs, acc[ai][bj][m][1] * rs); }
            return;
        }
#pragma unroll
        for (int ai = 0; ai < 2; ++ai) { RopeTab t[4];
#pragma unroll
            for (int m = 0; m < 4; ++m) t[m] = rope_load(cosb, sinb, ROW_OF, fq);
#pragma unroll
            for (int m = 0; m < 4; ++m) { const int row = ROW_OF; const float rs = RS_OF(lds) * QSCALE;
#pragma unroll
                for (int bj = 0; bj < 2; ++bj) { f32x4 v0 = acc[ai][bj][m][0] * rs, v1 = acc[ai][bj][m][1] * rs; rope8(v0, v1, t[m], fq);
                    *(u32x4*)(QR + (size_t)row * 512 + (u.pn - 4) * 256 + bj * 128 + wc * 32 + 8 * fq) = pack8(v0, v1); } } }
    }
};
struct EpiSwigluF8 { unsigned char* H8; int ldh; int row_sub; float sc;
    __device__ __forceinline__ void operator()(EPI_ARGS) const {
#pragma unroll
        for (int ai = 0; ai < 2; ++ai)
#pragma unroll
            for (int mp = 0; mp < 4; mp += 2) { u32x2 w[2];
#pragma unroll
                for (int q = 0; q < 2; ++q) { const int m = mp + q;
                    f32x4 g0 = acc[ai][0][m][0] * sc, g1 = acc[ai][0][m][1] * sc; const f32x4 u0 = acc[ai][1][m][0] * (sc * FS_H), u1 = acc[ai][1][m][1] * (sc * FS_H);
#pragma unroll
                    for (int e = 0; e < 4; ++e) { g0[e] = silu_f(g0[e]) * u0[e]; g1[e] = silu_f(g1[e]) * u1[e]; }
                    w[q] = (u32x2){pack4_fp8(g0), pack4_fp8(g1)}; }
                const auto s0 = __builtin_amdgcn_permlane16_swap(w[0].x, w[1].x, false, false), s1 = __builtin_amdgcn_permlane16_swap(w[0].y, w[1].y, false, false);
                const int m = mp + (fq & 1), row = ROW_OF;
                *(u32x4*)(H8 + (size_t)(row - row_sub) * ldh + u.pn * 128 + wc * 32 + 16 * (fq >> 1)) = (u32x4){s0[0], s1[0], s0[1], s1[1]}; }
    }
};
struct EpiSlab { bf16* S; float sc;
    __device__ __forceinline__ void operator()(EPI_ARGS) const {
        FOR_ROWS { const int row = ROW_OF;
#pragma unroll
            for (int bj = 0; bj < 2; ++bj) *(u32x4*)(S + ((size_t)u.ord * 2048 + (row - 65536)) * DM + u.pn * 256 + bj * 128 + wc * 32 + 8 * fq) = pack8(acc[ai][bj][m][0] * sc, acc[ai][bj][m][1] * sc); }
    }
};
struct EpiPlain { bf16* O; int ldo; int rmask; float sc;
    __device__ __forceinline__ void operator()(EPI_ARGS) const {
        FOR_ROWS { const int row = ROW_OF;
#pragma unroll
            for (int bj = 0; bj < 2; ++bj) *(u32x4*)(O + (size_t)(row & rmask) * ldo + u.pn * 256 + bj * 128 + wc * 32 + 8 * fq) = pack8(acc[ai][bj][m][0] * sc, acc[ai][bj][m][1] * sc); }
    }
};
}

namespace attn {
constexpr int KSLOT = 12288, VSLOT = 8192;
constexpr int NKS = 4, NVS = 3;
constexpr int L_K = 0, L_V = NKS * KSLOT, L_WS = L_V + NVS * VSLOT, L_OST = L_WS + 8 * 64 * 4, L_BYTES = L_OST + 8 * 4096;
__device__ __forceinline__ int crow(int r, int hi) { return (r & 3) + 8 * (r >> 2) + 4 * hi; }
__device__ __forceinline__ float max3f(float a, float b, float c) { return __builtin_fmaxf(__builtin_fmaxf(a, b), c); }

__device__ __forceinline__ float xhalf_max(float m) { auto rr = __builtin_amdgcn_permlane32_swap(__float_as_uint(m), __float_as_uint(m), false, false); return __builtin_fmaxf(__uint_as_float(rr[0]), __uint_as_float(rr[1])); }
__device__ __forceinline__ float xhalf_sum(float m) { auto rr = __builtin_amdgcn_permlane32_swap(__float_as_uint(m), __float_as_uint(m), false, false); return __uint_as_float(rr[0]) + __uint_as_float(rr[1]); }
__device__ __forceinline__ float rowmax32(const f32x16& p0, const f32x16& p1) {
    float a = max3f(p0[0], p0[1], p1[0]), b = max3f(p0[2], p0[3], p1[1]); a = max3f(a, p1[2], p1[3]);
#pragma unroll
    for (int r = 4; r < 16; r += 4) { a = max3f(a, p0[r], p0[r + 1]); b = max3f(b, p0[r + 2], p0[r + 3]); a = max3f(a, p1[r], p1[r + 1]); b = max3f(b, p1[r + 2], p1[r + 3]); }
    return xhalf_max(__builtin_fmaxf(a, b));
}
template <int ORD> __device__ __forceinline__ void attn_unit(int b, int h, int qb, const bf16* QN, const bf16* QR, const bf16* KN, const bf16* KR, const bf16* VB, bf16* O, LAS unsigned char* shm) {
    int tid_ = threadIdx.x; asm volatile("" : "+v"(tid_));
    const int tid = tid_, lane = tid & 63, r32 = lane & 31, hi = lane >> 5; const int wid = __builtin_amdgcn_readfirstlane(tid >> 6);
    const long rowbase = (long)b * SEQ; const int q0 = qb * 256;
    const int NT = (q0 + 256) / 64;
    const int tmax = (q0 + 32 * wid) >> 6;
    LAS float* wsf = (LAS float*)(shm + L_WS) + wid * 64;
    const bf16* ksrc0 = KN + (rowbase + lane) * DM + h * 64 + wid * 8;
    const bf16* ksrc1 = KR + (rowbase + lane) * 32 + (wid & 3) * 8;
    const bf16* vsrc = VB + (rowbase + 16 * (wid & 3) + (lane >> 2)) * DM + h * 64 + (wid >> 2) * 32 + (lane & 3) * 8;
#define DMA_K(t, s) do { \
        __builtin_amdgcn_global_load_lds((const unsigned*)(ksrc0 + (long)(t) * 64 * DM), (LAS unsigned*)(shm + L_K + (s) * KSLOT + wid * 1024), 16, 0, 0); \
        if (wid < 4) __builtin_amdgcn_global_load_lds((const unsigned*)(ksrc1 + (long)(t) * 64 * 32), (LAS unsigned*)(shm + L_K + (s) * KSLOT + (8 + wid) * 1024), 16, 0, 0); } while (0)
#define DMA_V(t, s) __builtin_amdgcn_global_load_lds((const unsigned*)(vsrc + (long)(t) * 64 * DM), (LAS unsigned*)(shm + L_V + (s) * VSLOT + wid * 1024), 16, 0, 0)
    DMA_K(0, 0); DMA_V(0, 0); DMA_K(1, 1); DMA_K(2, 2);
    bf16x8 qr[6];
    { const long qrow = rowbase + q0 + wid * 32 + r32;
#pragma unroll
      for (int d0 = 0; d0 < 4; ++d0) qr[d0] = *(const bf16x8*)(QN + qrow * DM + h * 64 + d0 * 16 + hi * 8);
#pragma unroll
      for (int d0 = 0; d0 < 2; ++d0) qr[4 + d0] = *(const bf16x8*)(QR + qrow * 512 + h * 32 + d0 * 16 + hi * 8); }
    float mhat = 0.f, l_reg = 0.f; f32x16 o[2]; o[0] = f32x16{}; o[1] = f32x16{}; f32x16 negm = f32x16{};
    const unsigned vbase = (unsigned)(uintptr_t)(shm + L_V) + ((lane >> 4) & 1) * 32 + (lane & 3) * 8 + (4 * hi + ((lane & 15) >> 2)) * 64;
    const LAS unsigned char* kbase = shm + L_K + hi * 1024 + r32 * 16;
#define QKT(P0, P1, s) do { const LAS unsigned char* kb_ = kbase + (s) * KSLOT; \
        _Pragma("unroll") for (int d0 = 0; d0 < 6; ++d0) { const bf16x8 b0_ = *(const LAS bf16x8*)(kb_ + d0 * 2048), b1_ = *(const LAS bf16x8*)(kb_ + d0 * 2048 + 512); \
            if (d0 == 0) { P0 = __builtin_amdgcn_mfma_f32_32x32x16_bf16(b0_, qr[0], negm, 0, 0, 0); P1 = __builtin_amdgcn_mfma_f32_32x32x16_bf16(b1_, qr[0], negm, 0, 0, 0); } \
            else { P0 = __builtin_amdgcn_mfma_f32_32x32x16_bf16(b0_, qr[d0], P0, 0, 0, 0); P1 = __builtin_amdgcn_mfma_f32_32x32x16_bf16(b1_, qr[d0], P1, 0, 0, 0); } } } while (0)
#define VF(i) (bf16x8){lo[i][0], lo[i][1], lo[i][2], lo[i][3], hh[i][0], hh[i][1], hh[i][2], hh[i][3]}
#define PV(PW, tt) do { const unsigned vb = vbase + ((tt) % 3) * VSLOT; s16x4 lo[8], hh[8]; \
        _Pragma("unroll") for (int i = 0; i < 8; ++i) { \
            asm volatile("ds_read_b64_tr_b16 %0,%1 offset:%c2" : "=&v"(lo[i]) : "v"(vb), "i"((i >> 2) * 4096 + (i & 3) * 1024) : "memory"); \
            asm volatile("ds_read_b64_tr_b16 %0,%1 offset:%c2" : "=&v"(hh[i]) : "v"(vb), "i"((i >> 2) * 4096 + (i & 3) * 1024 + 512) : "memory"); } \
        asm volatile("s_waitcnt lgkmcnt(0)" : "+v"(lo[0]), "+v"(lo[1]), "+v"(lo[2]), "+v"(lo[3]), "+v"(lo[4]), "+v"(lo[5]), "+v"(lo[6]), "+v"(lo[7]), \
                     "+v"(hh[0]), "+v"(hh[1]), "+v"(hh[2]), "+v"(hh[3]), "+v"(hh[4]), "+v"(hh[5]), "+v"(hh[6]), "+v"(hh[7]) :: "memory");     \
        o[0] = __builtin_amdgcn_mfma_f32_32x32x16_bf16(__builtin_bit_cast(bf16x8, PW[0]), VF(0), o[0], 0, 0, 0); o[1] = __builtin_amdgcn_mfma_f32_32x32x16_bf16(__builtin_bit_cast(bf16x8, PW[0]), VF(4), o[1], 0, 0, 0); \
        o[0] = __builtin_amdgcn_mfma_f32_32x32x16_bf16(__builtin_bit_cast(bf16x8, PW[1]), VF(1), o[0], 0, 0, 0); o[1] = __builtin_amdgcn_mfma_f32_32x32x16_bf16(__builtin_bit_cast(bf16x8, PW[1]), VF(5), o[1], 0, 0, 0); \
        o[0] = __builtin_amdgcn_mfma_f32_32x32x16_bf16(__builtin_bit_cast(bf16x8, PW[2]), VF(2), o[0], 0, 0, 0); o[1] = __builtin_amdgcn_mfma_f32_32x32x16_bf16(__builtin_bit_cast(bf16x8, PW[2]), VF(6), o[1], 0, 0, 0); \
        o[0] = __builtin_amdgcn_mfma_f32_32x32x16_bf16(__builtin_bit_cast(bf16x8, PW[3]), VF(3), o[0], 0, 0, 0); o[1] = __builtin_amdgcn_mfma_f32_32x32x16_bf16(__builtin_bit_cast(bf16x8, PW[3]), VF(7), o[1], 0, 0, 0); } while (0)
#define OSCALE() do { LDS_WAIT(); _Pragma("unroll") for (int d = 0; d < 2; ++d) _Pragma("unroll") for (int r = 0; r < 16; ++r) o[d][r] *= wsf[crow(r, hi)]; } while (0)
#define MBLOCK(N0, N1, PWP, t, ORD) do { \
        if ((t) >= 1 && (t) - 1 <= tmax) PV(PWP, (t) - 1); \
        if ((ORD) == 1 && resc) OSCALE(); \
        if (nx) QKT(N0, N1, ((t) + 1) & 3); } while (0)
#define VBLOCK(C0, C1, N0, N1, PWN, t, ORD) do { \
        const float rm = rowmax32(C0, C1); \
        if ((t) == 0 || __any(rm > 8.0f)) { \
            const float dl = (t) == 0 ? rm : __builtin_fmaxf(rm, 0.f); mhat += dl; \
            _Pragma("unroll") for (int r = 0; r < 16; ++r) { C0[r] -= dl; C1[r] -= dl; negm[r] = -mhat; } \
            if ((ORD) == 0 && nx) { _Pragma("unroll") for (int r = 0; r < 16; ++r) { N0[r] -= dl; N1[r] -= dl; } }     \
            const float f = fast_exp2(-dl); l_reg *= f; \
            if ((t) != 0) { if (hi == 0) wsf[r32] = f; if ((ORD) == 0) OSCALE(); else resc = true; } } \
        float sacc = 0.f; \
        _Pragma("unroll") for (int r = 0; r < 16; ++r) { C0[r] = fast_exp2(C0[r]); C1[r] = fast_exp2(C1[r]); sacc += C0[r] + C1[r]; } \
        l_reg += sacc; \
        PWN[0] = (u32x4){cvt_pk_bf16(C0[0], C0[1]), cvt_pk_bf16(C0[2], C0[3]), cvt_pk_bf16(C0[4], C0[5]), cvt_pk_bf16(C0[6], C0[7])}; \
        PWN[1] = (u32x4){cvt_pk_bf16(C0[8], C0[9]), cvt_pk_bf16(C0[10], C0[11]), cvt_pk_bf16(C0[12], C0[13]), cvt_pk_bf16(C0[14], C0[15])}; \
        PWN[2] = (u32x4){cvt_pk_bf16(C1[0], C1[1]), cvt_pk_bf16(C1[2], C1[3]), cvt_pk_bf16(C1[4], C1[5]), cvt_pk_bf16(C1[6], C1[7])}; \
        PWN[3] = (u32x4){cvt_pk_bf16(C1[8], C1[9]), cvt_pk_bf16(C1[10], C1[11]), cvt_pk_bf16(C1[12], C1[13]), cvt_pk_bf16(C1[14], C1[15])}; } while (0)
#define STEP(C0, C1, N0, N1, PWP, PWN, t, ORD) do { \
        if ((t) + 2 < NT) asm volatile("s_waitcnt vmcnt(2) lgkmcnt(0)\n\ts_barrier" ::: "memory");     \
        else asm volatile("s_waitcnt vmcnt(1) lgkmcnt(0)\n\ts_barrier" ::: "memory"); \
        if ((t) + 3 < NT) DMA_K((t) + 3, ((t) + 3) & 3); \
        if ((t) + 1 < NT) DMA_V((t) + 1, ((t) + 1) % 3); \
        const bool nx = ((t) + 1 <= tmax) && ((t) + 1 < NT); bool resc = false; \
        if ((ORD) == 0) { MBLOCK(N0, N1, PWP, t, 0); if ((t) <= tmax) VBLOCK(C0, C1, N0, N1, PWN, t, 0); } \
        else { if ((t) <= tmax) VBLOCK(C0, C1, N0, N1, PWN, t, 1); MBLOCK(N0, N1, PWP, t, 1); } } while (0)
    f32x16 pA0, pA1, pB0, pB1; u32x4 pwX[4], pwY[4];
    asm volatile("s_waitcnt vmcnt(0) lgkmcnt(0)\n\ts_barrier" ::: "memory");
    QKT(pA0, pA1, 0);
    for (int t = 0; t < NT; t += 2) { STEP(pA0, pA1, pB0, pB1, pwY, pwX, t, ORD); STEP(pB0, pB1, pA0, pA1, pwX, pwY, t + 1, ORD); }
    asm volatile("s_waitcnt vmcnt(0) lgkmcnt(0)\n\ts_barrier" ::: "memory");
    if (tmax >= NT - 1) PV(pwY, NT - 1);
#undef STEP
#undef VBLOCK
#undef MBLOCK
#undef OSCALE
#undef PV
#undef VF
#undef QKT
    l_reg = xhalf_sum(l_reg);
    if (hi == 0) wsf[32 + r32] = l_reg; LDS_WAIT();
    bf16* Ow = O + (rowbase + q0 + wid * 32) * DM + h * 64;
    { LAS bf16* stg = (LAS bf16*)(shm + L_OST) + wid * 2048;
#pragma unroll
      for (int r = 0; r < 16; ++r) { const int orow = crow(r, hi); const float rl = fast_rcp(wsf[32 + orow]);
#pragma unroll
          for (int d0 = 0; d0 < 2; ++d0) stg[orow * 64 + d0 * 32 + r32] = (bf16)(cvt_pk_bf16(o[d0][r] * rl, 0.f) & 0xffffu); }
      LDS_WAIT();
#pragma unroll
      for (int i = 0; i < 4; ++i) { const int row = i * 8 + (lane >> 3), ch = lane & 7; const u32x4 v = *(const LAS u32x4*)(stg + row * 64 + ch * 8); *(u32x4*)(Ow + (long)row * DM + ch * 8) = v; } }
    asm volatile("s_waitcnt lgkmcnt(0)\n\ts_barrier" ::: "memory");
#undef DMA_K
#undef DMA_V
}
}

#define XB_TMO      128
#define XB_XCNT(j)  (256  + 64 * (j))
#define XB_XSUB(j)  (1280 + 64 * (j))
#define XB_XGEN(j)  (2304 + 64 * (j))
#define XB_TOP      3328
#define XB_TOPGEN   3392
#define XCD_BAR_WORDS 3456
#define XB_SPIN_CAP (1u << 22)
__device__ __forceinline__ unsigned xb_ld(unsigned* p)              { return __hip_atomic_load(p, __ATOMIC_RELAXED, __HIP_MEMORY_SCOPE_AGENT); }
__device__ __forceinline__ unsigned xb_add(unsigned* p, unsigned v) { return __hip_atomic_fetch_add(p, v, __ATOMIC_RELAXED, __HIP_MEMORY_SCOPE_AGENT); }
__device__ __forceinline__ unsigned xb_xcc_id() { return (unsigned)__builtin_amdgcn_s_getreg((3 << 11) | 20) & 0xFu; }
#define XB_SPIN(cond, bar) do { unsigned _sp = 0; while (cond) { __builtin_amdgcn_s_sleep(1); \
    if ((++_sp & 255u) == 0u) { if (xb_ld(&(bar)[XB_TMO])) break; if (_sp > XB_SPIN_CAP) { atomicAdd(&(bar)[XB_TMO], 1u); break; } } } } while (0)
struct XcdBarrier { unsigned* bar; unsigned x; volatile LAS unsigned* st; };
__device__ __forceinline__ XcdBarrier xcd_barrier_post(unsigned* bar, volatile LAS unsigned* st) {
    XcdBarrier b; b.bar = bar; b.x = xb_xcc_id(); b.st = st;
    if (threadIdx.x == 0) (void)xb_add(&bar[XB_XCNT(b.x)], 1u);
    return b;
}
__device__ __forceinline__ void xcd_barrier_complete(unsigned* bar, unsigned x, unsigned& nloc, unsigned& nx) {
    const unsigned G = gridDim.x * gridDim.y * gridDim.z;
    unsigned sum, cnt, mine, sp = 0u;
    for (;;) {
        sum = 0u; cnt = 0u; mine = 0u;
#pragma unroll
        for (unsigned j = 0; j < 16; ++j) { const unsigned c = xb_ld(&bar[XB_XCNT(j)]); sum += c; cnt += (c > 0u) ? 1u : 0u; mine = (j == x) ? c : mine; }
        if (sum == G) break;
        __builtin_amdgcn_s_sleep(1);
        if ((++sp & 255u) == 0u) { if (xb_ld(&bar[XB_TMO])) break; if (sp > XB_SPIN_CAP) { atomicAdd(&bar[XB_TMO], 1u); break; } }
    }
    nloc = mine > 0u ? mine : 1u; nx = cnt > 0u ? cnt : 1u;
}
__device__ __forceinline__ void xcd_barrier(const XcdBarrier& b) {
    asm volatile("s_waitcnt vmcnt(0)" ::: "memory");
    __syncthreads();
    if (threadIdx.x == 0) {
        unsigned* bar = b.bar;
        __builtin_amdgcn_s_waitcnt(0);
        unsigned nloc = b.st[0], nx = b.st[1];
        if (nloc == 0u) { xcd_barrier_complete(bar, b.x, nloc, nx); b.st[0] = nloc; b.st[1] = nx; }
        const unsigned old = xb_add(&bar[XB_XSUB(b.x)], 1u);
        const unsigned gen = old / nloc;
        if (old + 1u == (gen + 1u) * nloc) {
            __builtin_amdgcn_fence(__ATOMIC_RELEASE, "agent");
            asm volatile("s_waitcnt vmcnt(0)" ::: "memory");
            const unsigned og = xb_add(&bar[XB_TOP], 1u);
            const unsigned tg = og / nx;
            if (og + 1u == (tg + 1u) * nx) xb_add(&bar[XB_TOPGEN], 1u);
            else XB_SPIN(xb_ld(&bar[XB_TOPGEN]) == tg, bar);
            __builtin_amdgcn_fence(__ATOMIC_ACQUIRE, "agent");
            xb_add(&bar[XB_XGEN(b.x)], 1u);
            asm volatile("s_waitcnt vmcnt(0)" ::: "memory");
        } else {
            XB_SPIN(xb_ld(&bar[XB_XGEN(b.x)]) == gen, bar);
            __builtin_amdgcn_fence(__ATOMIC_ACQUIRE, "agent");
            asm volatile("s_waitcnt vmcnt(0)" ::: "memory");
        }
    }
    __syncthreads();
}

__device__ __forceinline__ void pg8::OrderMoe::unit_sync() const { if (gb_bar) { XcdBarrier b; b.bar = gb_bar; b.x = gb_x; b.st = gb_st; xcd_barrier(b); } }
constexpr int NWAVES = 8;
constexpr int RING_BYTES = 131072, LDS_BYTES = 147456, MISC_OFF = LDS_BYTES - 256;
struct Args { const float* in[31]; float* out; unsigned char* ws; int ph_lo, ph_hi, probe, breg; };
enum { I_X = 0, I_POS, I_NMIX, I_NFFN, I_NFIN, I_S5WIN, I_LRE, I_LIM, I_LDT, I_BRE, I_BIM, I_CRE, I_CIM, I_S5D, I_S5WGLU, I_S5WOUT, I_KVNORM, I_WDKV, I_KVLN, I_WUKV, I_WDQ, I_QLN, I_WUQ, I_WO,
       I_FG, I_FU, I_FD, I_ROUTER, I_MG, I_MU, I_MD };
struct Frame { LAS unsigned char* lds; int tid, lane, wave, vcu, G; unsigned char* ws; };
#define FRESH_IDS(F) do { int t_ = threadIdx.x; asm volatile("" : "+v"(t_)); (F).tid = t_; (F).lane = t_ & 63; } while (0)
__device__ __forceinline__ const float* karg_in(int i) {
    auto kp = __builtin_amdgcn_kernarg_segment_ptr(); unsigned long long v;
    asm volatile("s_load_dwordx2 %0, %1, %2\n\ts_waitcnt lgkmcnt(0)" : "=s"(v) : "s"(kp), "i"(i * 8));
    return (const float*)v;
}
#define KIN(i) karg_in(i)

__device__ __forceinline__ void tr_block64(const float* W, int ldw, int k0, int n0, int nvalid, const float* gain, bf16* WT, int ldt, int dr0, int dr1, LAS float* scr, int lane) {
    const int r = lane >> 4, c4 = lane & 15; f32x4 v[16];
    const bool ok = 4 * c4 < nvalid;
#pragma unroll
    for (int i = 0; i < 16; ++i) v[i] = ok ? *(const f32x4*)(W + (size_t)(k0 + 4 * i + r) * ldw + n0 + 4 * c4) : (f32x4){0.f, 0.f, 0.f, 0.f};
    if (gain) {
#pragma unroll
        for (int i = 0; i < 16; ++i) v[i] = v[i] * gain[k0 + 4 * i + r]; }
#pragma unroll
    for (int i = 0; i < 16; ++i) { LAS float* d = scr + (4 * i + r) * 65 + 4 * c4; d[0] = v[i][0]; d[1] = v[i][1]; d[2] = v[i][2]; d[3] = v[i][3]; }
    LDS_WAIT(); asm volatile("" ::: "memory");
    const int kc = lane & 7, nr = lane >> 3;
#pragma unroll
    for (int j = 0; j < 8; ++j) { const int n = 8 * j + nr; const LAS float* s = scr + (8 * kc) * 65 + n;
        u32x4 o; o.x = cvt_pk_bf16(s[0 * 65], s[1 * 65]); o.y = cvt_pk_bf16(s[2 * 65], s[3 * 65]); o.z = cvt_pk_bf16(s[4 * 65], s[5 * 65]); o.w = cvt_pk_bf16(s[6 * 65], s[7 * 65]);
        if (n < nvalid) *(u32x4*)(WT + (size_t)(n < 32 ? dr0 + n : dr1 + n - 32) * ldt + k0 + 8 * kc) = o; }
    LDS_WAIT(); asm volatile("" ::: "memory");
}
__device__ __forceinline__ void tr_block64_f8(const float* W, int ldw, int k0, int n0, const float* gain, float scale, unsigned char* WT8, int ldt, int dr0, int dr1, LAS float* scr, int lane) {
    const int r = lane >> 4, c4 = lane & 15; f32x4 v[16];
#pragma unroll
    for (int i = 0; i < 16; ++i) v[i] = *(const f32x4*)(W + (size_t)(k0 + 4 * i + r) * ldw + n0 + 4 * c4);
#pragma unroll
    for (int i = 0; i < 16; ++i) v[i] = v[i] * (gain ? gain[k0 + 4 * i + r] * scale : scale);
#pragma unroll
    for (int i = 0; i < 16; ++i) { LAS float* d = scr + (4 * i + r) * 65 + 4 * c4; d[0] = v[i][0]; d[1] = v[i][1]; d[2] = v[i][2]; d[3] = v[i][3]; }
    LDS_WAIT(); asm volatile("" ::: "memory");
    const int kc = lane & 7, nr = lane >> 3;
#pragma unroll
    for (int j = 0; j < 8; ++j) { const int n = 8 * j + nr; const LAS float* s = scr + (8 * kc) * 65 + n;
        const u32x2 o = (u32x2){pack4_fp8((f32x4){s[0 * 65], s[1 * 65], s[2 * 65], s[3 * 65]}), pack4_fp8((f32x4){s[4 * 65], s[5 * 65], s[6 * 65], s[7 * 65]})};
        *(u32x2*)(WT8 + (size_t)(n < 32 ? dr0 + n : dr1 + n - 32) * ldt + k0 + 8 * kc) = o; }
    LDS_WAIT(); asm volatile("" ::: "memory");
}
template <int MAP> __device__ __forceinline__ void tr_item_f8(const float* W, int K, int N, const float* gain, float scale, unsigned char* WT8, int ldt, int row_off, LAS float* scr, int it, int lane);
enum { MAP_PLAIN = 0, MAP_GU_GATE, MAP_GU_UP, MAP_DKV, MAP_UKV, MAP_UQ };
template <int MAP> __device__ __forceinline__ int map_row(int n0, int row_off) {
    if (MAP == MAP_PLAIN) return row_off + n0;
    if (MAP == MAP_GU_GATE) return row_off + 256 * (n0 >> 7) + (n0 & 127);
    if (MAP == MAP_GU_UP) return row_off + 256 * (n0 >> 7) + 128 + (n0 & 127);
    if (MAP == MAP_DKV) return n0 < 256 ? n0 : 768 + (n0 - 256);
    if (MAP == MAP_UKV) { const int h = n0 >> 7, w = n0 & 127; return w < 64 ? h * 64 + w : 1024 + h * 64 + (w - 64); }
    { const int h = n0 / 96, w = n0 % 96; return w < 64 ? h * 64 + w : 1024 + h * 32 + (w - 64); }
}
template <int MAP> __device__ __forceinline__ void tr_item(const float* W, int K, int N, const float* gain, bf16* WT, int ldt, int row_off, LAS float* scr, int it, int lane) {
    const int nblk = (N + 63) / 64, kb = it / nblk, nb = it % nblk, n0 = 64 * nb; const int nvalid = (N - n0) < 64 ? (N - n0) : 64;
    tr_block64(W, N, 64 * kb, n0, nvalid, gain, WT, ldt, map_row<MAP>(n0, row_off), map_row<MAP>(n0 + 32, row_off), scr, lane);
}

template <int MAP> __device__ __forceinline__ void tr_item_f8(const float* W, int K, int N, const float* gain, float scale, unsigned char* WT8, int ldt, int row_off, LAS float* scr, int it, int lane) {
    const int nblk = N / 128, kb = it / nblk, nb = it % nblk, k0 = 128 * kb, n0 = 128 * nb;
    LAS unsigned* T = (LAS unsigned*)scr; const int kr = lane >> 5, c4 = lane & 31;
#pragma unroll 1
    for (int bt = 0; bt < 4; ++bt) {
        f32x4 v[4][4];
#pragma unroll
        for (int s = 0; s < 4; ++s)
#pragma unroll
            for (int kk = 0; kk < 4; ++kk) v[s][kk] = *(const f32x4*)(W + (size_t)(k0 + 4 * (8 * bt + 2 * s + kr) + kk) * N + n0 + 4 * c4);
#pragma unroll
        for (int s = 0; s < 4; ++s) { const int kq = 8 * bt + 2 * s + kr; float gsc[4];
#pragma unroll
            for (int kk = 0; kk < 4; ++kk) gsc[kk] = gain ? gain[k0 + 4 * kq + kk] * scale : scale;
#pragma unroll
            for (int c = 0; c < 4; ++c) T[(4 * c4 + c) * 33 + kq] = pack4_fp8((f32x4){v[s][0][c] * gsc[0], v[s][1][c] * gsc[1], v[s][2][c] * gsc[2], v[s][3][c] * gsc[3]}); }
    }
    LDS_WAIT(); asm volatile("" ::: "memory");
    const int kc = lane & 7, nr = lane >> 3;
#pragma unroll
    for (int j = 0; j < 16; ++j) { const int n = 8 * j + nr; const LAS unsigned* s = T + n * 33 + 4 * kc;
        const u32x4 o = (u32x4){s[0], s[1], s[2], s[3]};
        *(u32x4*)(WT8 + (size_t)map_row<MAP>(n0 + (n & ~31), row_off) * ldt + (size_t)(n & 31) * ldt + k0 + 16 * kc) = o; }
    LDS_WAIT(); asm volatile("" ::: "memory");
}
__device__ __forceinline__ void sincos_red(double r, double& s, double& c) {
    const double r2 = r * r; double ss = 1.0, cc = 1.0;
#pragma unroll
    for (int k = 13; k >= 1; --k) { ss = 1.0 - ss * r2 * (1.0 / (double)((2 * k) * (2 * k + 1))); cc = 1.0 - cc * r2 * (1.0 / (double)((2 * k - 1) * (2 * k))); }
    s = r * ss; c = cc;
}
__device__ __forceinline__ void sincos_d(double a, double& s, double& c) {
    const double k = __builtin_rint(a * 0.15915494309189535); const double r = (a - k * 6.283185307179586) - k * 2.4492935982947064e-16;
    sincos_red(r, s, c);
}

__device__ __forceinline__ void p0_s5_tables(Frame& F, const Args& A) {
    FRESH_IDS(F);
    LAS float* L = (LAS float*)F.lds;
    constexpr int CS = 68, KS = 272;
    LAS float* AP2 = L; LAS float* BBR = L + 33 * 64 * 2; LAS float* BBI = BBR + 1024; LAS float* CR = BBI + 1024; LAS float* CI = CR + 16 * CS; LAS float* KD = CI + 16 * CS;
    bf16* BT4 = (bf16*)(F.ws + WS_BT4); bf16* WEND = (bf16*)(F.ws + WS_WEND); float* A32 = (float*)(F.ws + WS_A32);
    const int t = F.tid;
    for (int item = F.vcu; item < SG * 4; item += F.G) {
        const int g = item >> 2, q = item & 3;
        if (t < 64) {
            const int p = t; const float* bre = KIN(I_BRE) + (size_t)(g * 64 + p) * 16; const float* bim = KIN(I_BIM) + (size_t)(g * 64 + p) * 16;
            f32x4 br4[4], bi4[4];
#pragma unroll
            for (int k = 0; k < 4; ++k) { br4[k] = *(const f32x4*)(bre + 4 * k); bi4[k] = *(const f32x4*)(bim + 4 * k); }
            const double dt = exp((double)KIN(I_LDT)[g]); const double lr = (double)KIN(I_LRE)[g * 64 + p], li = (double)KIN(I_LIM)[g * 64 + p];
            const double mag = exp(lr * dt); double s1, c1; sincos_d(li * dt, s1, c1);
            const double ar = mag * c1, ai = mag * s1, den = lr * lr + li * li, nr = ar - 1.0, ni = ai;
            const double cfr = (nr * lr + ni * li) / den, cfi = (ni * lr - nr * li) / den;
            double pr = 1.0, pi = 0.0;
            for (int l = 0; l <= 32; ++l) { AP2[(l * 64 + p) * 2] = (float)pr; AP2[(l * 64 + p) * 2 + 1] = (float)pi; const double nr2 = pr * ar - pi * ai, ni2 = pr * ai + pi * ar; pr = nr2; pi = ni2; }
            if (q == 0) { A32[(g * 64 + p) * 2] = AP2[(32 * 64 + p) * 2]; A32[(g * 64 + p) * 2 + 1] = AP2[(32 * 64 + p) * 2 + 1]; }
#pragma unroll
            for (int m = 0; m < 16; ++m) { const double br = (double)br4[m >> 2][m & 3], bi = (double)bi4[m >> 2][m & 3];
                BBR[p * 16 + m] = (float)(cfr * br - cfi * bi); BBI[p * 16 + m] = (float)(cfr * bi + cfi * br); }
        }
        { const float* cre = KIN(I_CRE) + (size_t)g * 1024; const float* cim = KIN(I_CIM) + (size_t)g * 1024;
          for (int e = t; e < 1024; e += 512) { const int n = e >> 6, p = e & 63; CR[n * CS + p] = cre[e]; CI[n * CS + p] = cim[e]; } }
        __syncthreads();
        { const int lo = F.lane & 15, kk = F.lane >> 4, ph = kk >> 1, c = kk & 1;
          float P[32], Q[32], Bv[32];
#pragma unroll
          for (int s = 0; s < 32; ++s) { const int p = 2 * s + ph; const float cr = CR[lo * CS + p], ci = CI[lo * CS + p]; P[s] = c ? -ci : cr; Q[s] = c ? -cr : -ci; Bv[s] = c ? BBI[p * 16 + lo] : BBR[p * 16 + lo]; }
          f32x4 acc[4];
#pragma unroll
          for (int j = 0; j < 4; ++j) acc[j] = (f32x4){0.f, 0.f, 0.f, 0.f};
          const LAS float* apw = AP2 + (4 * F.wave * 64 + ph) * 2;
#pragma unroll
          for (int s = 0; s < 32; ++s) {
#pragma unroll
              for (int j = 0; j < 4; ++j) { const f32x2 ap = *(const LAS f32x2*)(apw + (j * 64 + 2 * s) * 2); const float a = P[s] * ap[0] + Q[s] * ap[1];
                  acc[j] = __builtin_amdgcn_mfma_f32_16x16x4f32(a, Bv[s], acc[j], 0, 0, 0); } }
          const float dsk = KIN(I_S5D)[g * 16 + lo];
#pragma unroll
          for (int j = 0; j < 4; ++j) { const int l = 4 * F.wave + j;
#pragma unroll
              for (int r = 0; r < 4; ++r) { const int n = 4 * kk + r; float v = acc[j][r]; if (l == 0 && n == lo) v += dsk; KD[l * KS + n * 16 + lo] = v; } } }
        __syncthreads();
#pragma unroll 2
        for (int piece = t; piece < 128 * 64; piece += 512) {
            const int rl = piece >> 6, pc = piece & 63, i = 8 * q + (rl >> 4), n = rl & 15, j = pc >> 1, m0 = (pc & 1) * 8, lag = i - j;
            const LAS f32x4* kp = (const LAS f32x4*)(KD + (lag < 0 ? 0 : lag) * KS + n * 16 + m0);
            f32x4 v0 = kp[0], v1 = kp[1]; if (lag < 0) { v0 = (f32x4){0.f, 0.f, 0.f, 0.f}; v1 = v0; }
            *(u32x4*)(BT4 + ((size_t)g * 512 + 128 * q + rl) * UGLD + pc * 8) = pack8(v0, v1);
        }
#pragma unroll 2
        for (int piece = t; piece < 128 * 16; piece += 512) {
            const int rl = piece >> 4, pcb = piece & 15, i = 8 * q + (rl >> 4), n = rl & 15, ri = pcb >> 3, p0 = (pcb & 7) * 8;
            const LAS f32x4* cr4 = (const LAS f32x4*)(CR + n * CS + p0); const LAS f32x4* ci4 = (const LAS f32x4*)(CI + n * CS + p0); const LAS f32x4* ap4 = (const LAS f32x4*)(AP2 + ((i + 1) * 64 + p0) * 2);
            const f32x4 c0 = cr4[0], c1 = cr4[1], d0 = ci4[0], d1 = ci4[1], a0 = ap4[0], a1 = ap4[1], a2 = ap4[2], a3 = ap4[3];
            const f32x4 ar0 = (f32x4){a0[0], a0[2], a1[0], a1[2]}, ai0 = (f32x4){a0[1], a0[3], a1[1], a1[3]}, ar1 = (f32x4){a2[0], a2[2], a3[0], a3[2]}, ai1 = (f32x4){a2[1], a2[3], a3[1], a3[3]};
            f32x4 v0, v1; if (ri == 0) { v0 = c0 * ar0 - d0 * ai0; v1 = c1 * ar1 - d1 * ai1; } else { v0 = -(c0 * ai0 + d0 * ar0); v1 = -(c1 * ai1 + d1 * ar1); }
            *(u32x4*)(BT4 + ((size_t)g * 512 + 128 * q + rl) * UGLD + 512 + pcb * 8) = pack8(v0, v1);
        }
#pragma unroll 2
        for (int piece = t; piece < 32 * 64; piece += 512) {
            const int rl = piece >> 6, pc = piece & 63, qq = 32 * q + rl, ri = qq >> 6, p = qq & 63, j = pc >> 1, m0 = (pc & 1) * 8, l = 31 - j;
            const f32x2 ap = *(const LAS f32x2*)(AP2 + (l * 64 + p) * 2); const LAS f32x4* br4 = (const LAS f32x4*)(BBR + p * 16 + m0); const LAS f32x4* bi4 = (const LAS f32x4*)(BBI + p * 16 + m0);
            const f32x4 b0 = br4[0], b1 = br4[1], e0 = bi4[0], e1 = bi4[1];
            f32x4 v0, v1; if (ri == 0) { v0 = b0 * ap[0] - e0 * ap[1]; v1 = b1 * ap[0] - e1 * ap[1]; } else { v0 = e0 * ap[0] + b0 * ap[1]; v1 = e1 * ap[0] + b1 * ap[1]; }
            *(u32x4*)(WEND + ((size_t)g * 256 + qq) * UK + pc * 8) = pack8(v0, v1);
        }
        __syncthreads();
    }
}
__device__ __forceinline__ void p0_prologue(Frame& F, const Args& A) {
    FRESH_IDS(F);
    unsigned char* ws = F.ws;
    p0_s5_tables(F, A);
    __syncthreads();
    LAS float* scr = (LAS float*)(F.lds + F.wave * 16640);
    const int gw = F.vcu * NWAVES + F.wave, NGW = F.G * NWAVES;
    constexpr int I_SQ = 16 * 16, I_FGU = 16 * 42, I_FDN = 42 * 16, I_DKV = 16 * 5, I_DQ = 16 * 8, I_UKV = 4 * 32, I_UQ = 8 * 24;
    constexpr int NIT = 3 * I_SQ + 2 * I_FGU + I_FDN + I_DKV + I_DQ + I_UKV + I_UQ + I_SQ;
    for (int it = gw; it < NIT; it += NGW) {
        int r = it;
        if (r < I_SQ) { tr_item<MAP_PLAIN>(KIN(I_S5WIN), DM, DM, KIN(I_NMIX), (bf16*)(ws + WS_WIN), DM, 0, scr, r, F.lane); continue; } r -= I_SQ;
        if (r < I_SQ) { tr_item<MAP_PLAIN>(KIN(I_S5WGLU), DM, DM, nullptr, (bf16*)(ws + WS_WGLU), DM, 0, scr, r, F.lane); continue; } r -= I_SQ;
        if (r < I_SQ) { tr_item<MAP_PLAIN>(KIN(I_S5WOUT), DM, DM, nullptr, (bf16*)(ws + WS_WOUT), DM, 0, scr, r, F.lane); continue; } r -= I_SQ;
        if (r < I_FGU) { tr_item<MAP_GU_GATE>(KIN(I_FG), DM, DFF, KIN(I_NFFN), (bf16*)(ws + WS_WGU), DM, 0, scr, r, F.lane); continue; } r -= I_FGU;
        if (r < I_FGU) { tr_item<MAP_GU_UP>(KIN(I_FU), DM, DFF, KIN(I_NFFN), (bf16*)(ws + WS_WGU), DM, 0, scr, r, F.lane); continue; } r -= I_FGU;
        if (r < I_FDN) { tr_item<MAP_PLAIN>(KIN(I_FD), DFF, DM, nullptr, (bf16*)(ws + WS_WDOWN), DFF, 0, scr, r, F.lane); continue; } r -= I_FDN;
        if (r < I_DKV) { tr_item<MAP_DKV>(KIN(I_WDKV), DM, KVL + DROPE, KIN(I_KVNORM), (bf16*)(ws + WS_WKVQ), DM, 0, scr, r, F.lane); continue; } r -= I_DKV;
        if (r < I_DQ) { tr_item<MAP_PLAIN>(KIN(I_WDQ), DM, QL, KIN(I_NMIX) + DM, (bf16*)(ws + WS_WKVQ), DM, 256, scr, r, F.lane); continue; } r -= I_DQ;
        if (r < I_UKV) { tr_item<MAP_UKV>(KIN(I_WUKV), KVL, 2048, KIN(I_KVLN), (bf16*)(ws + WS_WUKV), KVL, 0, scr, r, F.lane); continue; } r -= I_UKV;
        if (r < I_UQ) { tr_item<MAP_UQ>(KIN(I_WUQ), QL, 1536, KIN(I_QLN), (bf16*)(ws + WS_WUQ), QL, 0, scr, r, F.lane); continue; } r -= I_UQ;
        tr_item<MAP_PLAIN>(KIN(I_WO), DM, DM, nullptr, (bf16*)(ws + WS_WO), DM, 0, scr, r, F.lane);
    }
    { const float* x = KIN(I_X); bf16* XB = (bf16*)(ws + WS_XB); float* ST = (float*)(ws + WS_ST);
      for (int m0 = gw * 4; m0 < M; m0 += NGW * 4) { f32x4 v[4][4]; float s[4];
#pragma unroll
          for (int a = 0; a < 4; ++a) { const f32x4* xr = (const f32x4*)(x + (size_t)(m0 + a) * DM) + F.lane;
#pragma unroll
              for (int j = 0; j < 4; ++j) v[a][j] = xr[64 * j]; }
#pragma unroll
          for (int a = 0; a < 4; ++a) { s[a] = 0.f;
#pragma unroll
              for (int j = 0; j < 4; ++j) s[a] += (v[a][j][0] * v[a][j][0] + v[a][j][1] * v[a][j][1]) + (v[a][j][2] * v[a][j][2] + v[a][j][3] * v[a][j][3]);
              s[a] = wave_sum(s[a]); }
#pragma unroll
          for (int a = 0; a < 4; ++a) { const int m = m0 + a; u32x2* o8 = (u32x2*)(XB + (size_t)m * DM) + F.lane;
#pragma unroll
              for (int j = 0; j < 4; ++j) o8[64 * j] = (u32x2){cvt_pk_bf16(v[a][j][0], v[a][j][1]), cvt_pk_bf16(v[a][j][2], v[a][j][3])};
              if (F.lane < 16) ST[(size_t)m * 16 + F.lane] = F.lane == 0 ? s[a] : 0.f; } } }
    { const int* pos = (const int*)KIN(I_POS); float* COS = (float*)(ws + WS_COS); float* SIN = (float*)(ws + WS_SIN);
      for (int e = F.vcu * 512 + F.tid; e < M * 16; e += F.G * 512) { const int row = e >> 4, c = e & 15;
          const int c4 = c & 3, c16 = c >> 2;
          const double b4 = c4 == 0 ? 1.0 : (c4 == 1 ? 0.5623413251903491 : (c4 == 2 ? 0.31622776601683794 : 0.1778279410038923));
          const double sc = c16 == 0 ? 1.0 : (c16 == 1 ? 0.1 : (c16 == 2 ? 0.01 : 0.001));
          double s, cc; sincos_d((double)pos[row] * (b4 * sc), s, cc); COS[e] = (float)cc; SIN[e] = (float)s; } }
    { float* RW = (float*)(ws + WS_ROUTW); const float* rw = KIN(I_ROUTER); const float* gn = KIN(I_NFFN) + DM;
      for (int e = F.vcu * 512 + F.tid; e < DM * NE; e += F.G * 512) RW[e] = rw[e] * gn[e >> 3]; }
}

__device__ __forceinline__ void scan_panel(Frame& F, int g, int pm) {
    FRESH_IDS(F);
    const int p = F.lane, line = F.wave >> 2, seg = F.wave & 3, b = 2 * pm + line;
    const float* E = (const float*)(F.ws + WS_E); bf16* UG = (bf16*)(F.ws + WS_UG); const float* A32 = (const float*)(F.ws + WS_A32);
    LAS float* XF_ = (LAS float*)F.lds;
    const float ar = A32[(g * 64 + p) * 2], ai = A32[(g * 64 + p) * 2 + 1];
    const size_t row0 = (size_t)g * BC + b * NCH + seg * 32;
    float er[32], ei[32];
#pragma unroll
    for (int k = 0; k < 32; ++k) { er[k] = E[(row0 + k) * 128 + p]; ei[k] = E[(row0 + k) * 128 + 64 + p]; }
    float lr = 0.f, li = 0.f;
#pragma unroll
    for (int k = 0; k < 32; ++k) { const float tr = er[k], ti = ei[k]; er[k] = lr; ei[k] = li; const float nr = ar * lr - ai * li + tr, ni = ar * li + ai * lr + ti; lr = nr; li = ni; }
    XF_[((line * 4 + seg) * 2 + 0) * 64 + p] = lr; XF_[((line * 4 + seg) * 2 + 1) * 64 + p] = li;
    float sr = ar, si = ai;
#pragma unroll
    for (int q = 0; q < 5; ++q) { const float nr = sr * sr - si * si, ni = 2.f * sr * si; sr = nr; si = ni; }
    __syncthreads();
    float cr = 0.f, ci = 0.f;
    for (int k = 0; k < seg; ++k) { const float fr = XF_[((line * 4 + k) * 2 + 0) * 64 + p], fi = XF_[((line * 4 + k) * 2 + 1) * 64 + p]; const float nr = sr * cr - si * ci + fr, ni = sr * ci + si * cr + fi; cr = nr; ci = ni; }
    float pr = cr, pi = ci;
#pragma unroll
    for (int k = 0; k < 32; ++k) { bf16* d = UG + (row0 + k) * UGLD + UK; d[p] = (bf16)(cvt_pk_bf16(er[k] + pr, 0.f) & 0xffffu); d[64 + p] = (bf16)(cvt_pk_bf16(ei[k] + pi, 0.f) & 0xffffu);
        const float nr = ar * pr - ai * pi, ni = ar * pi + ai * pr; pr = nr; pi = ni; }
}

__device__ __forceinline__ void p14_router(Frame& F, const Args& A) {
    FRESH_IDS(F);
    unsigned char* ws = F.ws;
    LAS float* RW = (LAS float*)F.lds; { const float* rw = (const float*)(ws + WS_ROUTW); for (int e = F.tid; e < DM * NE; e += 512) RW[e] = rw[e]; }
    __syncthreads();
    const bf16* XB = (const bf16*)(ws + WS_XB); u32x4* TOK = (u32x4*)(ws + WS_TOK); int* CNT = (int*)(ws + WS_CNT);
    const int gw = F.vcu * NWAVES + F.wave, NGW = F.G * NWAVES;
    for (int chunk = gw; chunk < M / 16; chunk += NGW) {
        int me0 = 0, me1 = 0; float mw0 = 0.f, mw1 = 0.f, mrs = 0.f;
#pragma unroll 1
        for (int t4 = 0; t4 < 16; t4 += 4) {
            u32x2 xv[4][4];
#pragma unroll
            for (int a = 0; a < 4; ++a) { const u32x2* xr = (const u32x2*)(XB + (size_t)(chunk * 16 + t4 + a) * DM) + F.lane;
#pragma unroll
                for (int j = 0; j < 4; ++j) xv[a][j] = xr[64 * j]; }
#pragma unroll
            for (int a = 0; a < 4; ++a) { const int tt = t4 + a; float lg[8]; float ss = 0.f;
#pragma unroll
                for (int e = 0; e < 8; ++e) lg[e] = 0.f;
#pragma unroll
                for (int j = 0; j < 4; ++j) { const f32x4 v = (f32x4){bflo(xv[a][j].x), bfhi(xv[a][j].x), bflo(xv[a][j].y), bfhi(xv[a][j].y)}; ss += (v[0] * v[0] + v[1] * v[1]) + (v[2] * v[2] + v[3] * v[3]);
#pragma unroll
                    for (int q = 0; q < 4; ++q) { const int k = 256 * j + 4 * F.lane + q; const f32x4 w0 = *(const LAS f32x4*)(RW + k * 8), w1 = *(const LAS f32x4*)(RW + k * 8 + 4);
                        lg[0] += v[q] * w0[0]; lg[1] += v[q] * w0[1]; lg[2] += v[q] * w0[2]; lg[3] += v[q] * w0[3]; lg[4] += v[q] * w1[0]; lg[5] += v[q] * w1[1]; lg[6] += v[q] * w1[2]; lg[7] += v[q] * w1[3]; } }
                ss = wave_sum(ss); const float rs = rsqrtf(ss * (1.0f / DM) + EPS);
#pragma unroll
                for (int e = 0; e < 8; ++e) lg[e] = wave_sum(lg[e]) * rs;
                int e0 = 0; float l0 = lg[0];
#pragma unroll
                for (int e = 1; e < 8; ++e) if (lg[e] > l0) { l0 = lg[e]; e0 = e; }
                int e1 = -1; float l1 = -INFINITY;
#pragma unroll
                for (int e = 0; e < 8; ++e) if (e != e0 && lg[e] > l1) { l1 = lg[e]; e1 = e; }
                const float w1 = 1.0f / (1.0f + expf(l0 - l1)), w0 = 1.0f - w1;
                if (F.lane == tt) { me0 = e0; me1 = e1; mw0 = w0; mw1 = w1; mrs = rs; }
            }
        }
        int r0 = 0, r1 = 0, mycnt = 0; const bool act = F.lane < 16;
#pragma unroll
        for (int e = 0; e < 8; ++e) { const unsigned long long mk = __ballot(act && (me0 == e || me1 == e)); const int rk = __popcll(mk & ((1ull << F.lane) - 1ull));
            if (act && me0 == e) r0 = rk; if (act && me1 == e) r1 = rk; if (F.lane == e) mycnt = __popcll(mk); }
        if (act) TOK[chunk * 16 + F.lane] = (u32x4){(unsigned)me0 | ((unsigned)me1 << 8) | ((unsigned)r0 << 16) | ((unsigned)r1 << 24), __builtin_bit_cast(unsigned, mw0), __builtin_bit_cast(unsigned, mw1), __builtin_bit_cast(unsigned, mrs)};
        if (F.lane < 8) CNT[chunk * 8 + F.lane] = mycnt;
    }
}

__device__ __forceinline__ void moe_weight_convert(Frame& F, unsigned char* wm, int rank, int nconv) {
    FRESH_IDS(F);
    unsigned char* ws = F.ws;
    LAS float* scr = (LAS float*)(F.lds + F.wave * 16896);
    constexpr int I_G = 8 * 28, I_D = 28 * 8, PER_E = 2 * I_G + I_D;
    const float* gn = KIN(I_NFFN) + DM; const int gw = rank * NWAVES + F.wave, NGW = nconv * NWAVES;
    for (int it = gw; it < NE * PER_E; it += NGW) {
        const int e = it / PER_E; int r = it % PER_E;
        if (r < I_G) { tr_item_f8<MAP_GU_GATE>(KIN(I_MG) + (size_t)e * DM * MFF, DM, MFF, gn, FS_W, wm + OUT_WMGU, DM, e * NMGU, scr, r, F.lane); continue; } r -= I_G;
        if (r < I_G) { tr_item_f8<MAP_GU_UP>(KIN(I_MU) + (size_t)e * DM * MFF, DM, MFF, gn, FS_W, wm + OUT_WMGU, DM, e * NMGU, scr, r, F.lane); continue; } r -= I_G;
        tr_item_f8<MAP_PLAIN>(KIN(I_MD) + (size_t)e * MFF * DM, MFF, DM, nullptr, FS_W, wm + OUT_WMDN, MFF, e * DM, scr, r, F.lane);
    }
}

__device__ __forceinline__ void p15_scatter(Frame& F, const Args& A) {
    FRESH_IDS(F);
    unsigned char* ws = F.ws; const int* CNT = (const int*)(ws + WS_CNT); int* MINFO = (int*)(ws + WS_MINFO);
    LAS int* LI = (LAS int*)F.lds;
    if (F.tid < 32) LI[F.tid] = 0;
    __syncthreads();
    const int NCHUNK = M / 16, gw0 = F.vcu * NWAVES;
    for (int pass = 0; pass * F.G * NWAVES < NCHUNK; ++pass) {
        const int cbase = pass * F.G * NWAVES + gw0;
        __syncthreads();
        if (F.tid < 16) LI[F.tid] = 0;
        __syncthreads();
        { int tot[8], pre[8];
#pragma unroll
          for (int e = 0; e < 8; ++e) { tot[e] = 0; pre[e] = 0; }
          for (int ch = F.tid; ch < NCHUNK; ch += 512) { const int4 a = *(const int4*)(CNT + ch * 8), b = *(const int4*)(CNT + ch * 8 + 4); const int m = ch < cbase ? 1 : 0;
              tot[0] += a.x; tot[1] += a.y; tot[2] += a.z; tot[3] += a.w; tot[4] += b.x; tot[5] += b.y; tot[6] += b.z; tot[7] += b.w;
              pre[0] += m * a.x; pre[1] += m * a.y; pre[2] += m * a.z; pre[3] += m * a.w; pre[4] += m * b.x; pre[5] += m * b.y; pre[6] += m * b.z; pre[7] += m * b.w; }
#pragma unroll
          for (int e = 0; e < 8; ++e) { int v = tot[e], w = pre[e];
#pragma unroll
              for (int o = 1; o < 64; o <<= 1) { v += __shfl_xor(v, o); w += __shfl_xor(w, o); }
              if (F.lane == 0) { atomicAdd((int*)&LI[e], v); atomicAdd((int*)&LI[8 + e], w); } } }
        __syncthreads();
        if (F.tid == 0) { int s = 0; for (int e = 0; e < 8; ++e) { LI[16 + e] = s; s += (LI[e] + 255) & ~255; }
            if (F.vcu == 0 && pass == 0) { int np = 0; for (int e = 0; e < 8; ++e) { MINFO[e] = LI[16 + e]; const int pe = (LI[e] + 255) >> 8; for (int k = 0; k < pe; ++k) MINFO[16 + np + k] = e; np += pe; } MINFO[8] = np; } }
        __syncthreads();
        const int chunk = cbase + F.wave;
        if (chunk < NCHUNK) {
            int wb = 0; if (F.lane < 8) { for (int w = 0; w < F.wave; ++w) wb += CNT[(cbase + w) * 8 + F.lane]; wb += LI[8 + F.lane] + LI[16 + F.lane]; }
            const u32x4* TOK = (const u32x4*)(ws + WS_TOK); int2* POS = (int2*)(ws + WS_POS);
            u32x4 tk = (u32x4){0u, 0u, 0u, 0u}; if (F.lane < 16) tk = TOK[chunk * 16 + F.lane];
            const int e0 = tk.x & 255, e1 = (tk.x >> 8) & 255, r0 = (tk.x >> 16) & 255, r1 = (tk.x >> 24) & 255;
            const int p0 = __shfl(wb, e0) + r0, p1 = __shfl(wb, e1) + r1;
            if (F.lane < 16) POS[chunk * 16 + F.lane] = make_int2(p0, p1);
            const bf16* XB = (const bf16*)(ws + WS_XB); unsigned char* HS = ws + WS_HS;
#pragma unroll 1
            for (int t8 = 0; t8 < 16; t8 += 4) {
                u32x2 v[4][4]; int q0[4], q1[4]; float rs[4];
#pragma unroll
                for (int a = 0; a < 4; ++a) { const int tt = t8 + a, tok = chunk * 16 + tt; q0[a] = __shfl(p0, tt); q1[a] = __shfl(p1, tt); rs[a] = u2f((unsigned)__shfl((int)tk.w, tt)) * FS_A;
                    const u32x2* xr = (const u32x2*)(XB + (size_t)tok * DM) + F.lane;
#pragma unroll
                    for (int j = 0; j < 4; ++j) v[a][j] = xr[64 * j]; }
#pragma unroll
                for (int a = 0; a < 4; ++a) { unsigned* d0 = (unsigned*)(HS + (size_t)q0[a] * DM) + F.lane; unsigned* d1 = (unsigned*)(HS + (size_t)q1[a] * DM) + F.lane;
#pragma unroll
                    for (int j = 0; j < 4; ++j) { const unsigned w = pack4_fp8((f32x4){bflo(v[a][j].x), bfhi(v[a][j].x), bflo(v[a][j].y), bfhi(v[a][j].y)} * rs[a]); d0[64 * j] = w; d1[64 * j] = w; } }
            }
        }
    }
}

__device__ __forceinline__ void p_final(Frame& F, const Args& A) {
    FRESH_IDS(F);
    unsigned char* ws = F.ws; const u32x4* TOK = (const u32x4*)(ws + WS_TOK); const int2* POS = (const int2*)(ws + WS_POS); const bf16* YS = (const bf16*)(ws + WS_YS); float* XF = A.out; const bf16* XB = (const bf16*)(ws + WS_XB); const float* gf = KIN(I_NFIN);
    const int gw = F.vcu * NWAVES + F.wave, NGW = F.G * NWAVES; const bf16* SL = (const bf16*)(ws + WS_SLAB);
    for (int tok0 = gw * 2; tok0 < M; tok0 += NGW * 2) {
        u32x4 tk[2]; int2 ps[2]; u32x2 x[2][4]; u32x2 ya[2][4], yb[2][4];
#pragma unroll
        for (int a = 0; a < 2; ++a) { tk[a] = TOK[tok0 + a]; ps[a] = POS[tok0 + a]; }
#pragma unroll
        for (int a = 0; a < 2; ++a) { const u32x2* xr = (const u32x2*)(XB + (size_t)(tok0 + a) * DM) + F.lane;
            const int pa = ps[a].x < 65536 ? ps[a].x : 0, pb = ps[a].y < 65536 ? ps[a].y : 0;
            const u32x2* y0 = (const u32x2*)(YS + (size_t)pa * DM) + F.lane; const u32x2* y1 = (const u32x2*)(YS + (size_t)pb * DM) + F.lane;
#pragma unroll
            for (int j = 0; j < 4; ++j) { x[a][j] = xr[64 * j]; ya[a][j] = y0[64 * j]; yb[a][j] = y1[64 * j]; } }
#pragma unroll
        for (int a = 0; a < 2; ++a) { const int tok = tok0 + a; const float w0 = DBG_MOE * u2f(tk[a].y), w1 = DBG_MOE * u2f(tk[a].z);
            f32x4 v[4]; float ss = 0.f;
#pragma unroll
            for (int j = 0; j < 4; ++j) { f32x4 fa, fb;
                if (ps[a].x < 65536) fa = (f32x4){bflo(ya[a][j].x), bfhi(ya[a][j].x), bflo(ya[a][j].y), bfhi(ya[a][j].y)};
                else { fa = (f32x4){0.f, 0.f, 0.f, 0.f}; for (int k = 0; k < pg8::KSPLIT; ++k) { const u32x2 q = *((const u32x2*)(SL + ((size_t)k * 2048 + (ps[a].x - 65536)) * DM) + F.lane + 64 * j); fa += (f32x4){bflo(q.x), bfhi(q.x), bflo(q.y), bfhi(q.y)}; } }
                if (ps[a].y < 65536) fb = (f32x4){bflo(yb[a][j].x), bfhi(yb[a][j].x), bflo(yb[a][j].y), bfhi(yb[a][j].y)};
                else { fb = (f32x4){0.f, 0.f, 0.f, 0.f}; for (int k = 0; k < pg8::KSPLIT; ++k) { const u32x2 q = *((const u32x2*)(SL + ((size_t)k * 2048 + (ps[a].y - 65536)) * DM) + F.lane + 64 * j); fb += (f32x4){bflo(q.x), bfhi(q.x), bflo(q.y), bfhi(q.y)}; } }
                v[j] = (f32x4){bflo(x[a][j].x), bfhi(x[a][j].x), bflo(x[a][j].y), bfhi(x[a][j].y)} + w0 * fa + w1 * fb;
                ss += (v[j][0] * v[j][0] + v[j][1] * v[j][1]) + (v[j][2] * v[j][2] + v[j][3] * v[j][3]); }
            ss = wave_sum(ss); const float rs = rsqrtf(ss * (1.0f / DM) + EPS);
            f32x4* xo = (f32x4*)(XF + (size_t)tok * DM) + F.lane;
#pragma unroll
            for (int j = 0; j < 4; ++j) { const f32x4 gg = *((const f32x4*)gf + 64 * j + F.lane); xo[64 * j] = v[j] * rs * gg; } }
    }
}

constexpr int PH_PRO = 0, PH_WIN = 1, PH_S5 = 2, PH_GLU = 3, PH_WOUT = 4, PH_FGU = 5, PH_FDN = 6, PH_KVQ = 7, PH_UKVQ = 8, PH_ATT = 9, PH_WO = 10, PH_ROUTE = 11, PH_SCAT = 12,
              PH_MOE0 = 13, PH_FINAL = PH_MOE0 + 3, N_PHASES = PH_FINAL + 1;

__global__ void __launch_bounds__(NWAVES * 64, 2) yoco_fwd(Args args) {
    extern __shared__ __attribute__((aligned(16))) unsigned char lds[];
    Frame F; F.lds = (LAS unsigned char*)lds; F.tid = threadIdx.x; F.lane = F.tid & 63; F.wave = __builtin_amdgcn_readfirstlane(F.tid >> 6);
    F.G = gridDim.x; { const int bx = blockIdx.x; F.vcu = (F.G % 8 == 0) ? (bx % 8) * (F.G / 8) + bx / 8 : bx; }
    F.ws = args.ws; unsigned char* ws = args.ws;
    volatile LAS unsigned* MISC = (volatile LAS unsigned*)(F.lds + MISC_OFF);
    for (int u = F.tid; u < (LDS_BYTES - MISC_OFF) / 4; u += NWAVES * 64) ((LAS unsigned*)(F.lds + MISC_OFF))[u] = 0u;
    __syncthreads();
    const int lo = args.ph_lo, hi = args.ph_hi;
    XcdBarrier bar; bar.bar = (unsigned*)(ws + WS_CTL) + CW_BAR + args.breg * XCD_BAR_WORDS; bar.x = 0; bar.st = nullptr;
    if (hi - lo > 1 || args.probe == 13) bar = xcd_barrier_post((unsigned*)(ws + WS_CTL) + CW_BAR + args.breg * XCD_BAR_WORDS, MISC + 8);
#define IN(k) (lo <= (k) && (k) < hi)
#define SEAM(k) do { if (IN(k) && IN((k) + 1)) xcd_barrier(bar); } while (0)
    const int bx = (int)blockIdx.x;
    bf16* XB = (bf16*)(ws + WS_XB); float* ST = (float*)(ws + WS_ST);

    if (IN(PH_PRO)) { p0_prologue(F, args); __syncthreads(); } SEAM(PH_PRO);

    if (IN(PH_WIN)) {
        pg8::Gemm g{XB, (const bf16*)(ws + WS_WIN), DM, DM, DM, 0, 0}; pg8::Order2D S; S.init(M / 256, DM / 256, F.G, bx);
        pg8::build_rs_table<16>(F.lds, ST, S, 1.0f / DM); pg8::EpiUin E{F.lds, (bf16*)(ws + WS_UG)}; pg8::gemm_phase(F.lds, g, S, E); } SEAM(PH_WIN);

    if (IN(PH_S5)) {
#pragma unroll 1
        for (int item = F.vcu; item < SG * 4; item += F.G) {
            const int gq = item >> 2, pm = item & 3;
            { pg8::Gemm g{(const bf16*)(ws + WS_UG), (const bf16*)(ws + WS_WEND), UGLD, UK, UK, (size_t)BC * UGLD * 2, (size_t)256 * UK * 2}; pg8::OrderPanel S{gq, pm, 1};
              pg8::EpiEnd E{(float*)(ws + WS_E)}; pg8::gemm_phase(F.lds, g, S, E); }
            scan_panel(F, gq, pm);
            VM_WAIT(); __syncthreads();
            { pg8::Gemm g{(const bf16*)(ws + WS_UG), (const bf16*)(ws + WS_BT4), UGLD, UGLD, UGLD, (size_t)BC * UGLD * 2, (size_t)512 * UGLD * 2}; pg8::OrderPanel S{gq, pm, 2};
              pg8::EpiS5Y E{(bf16*)(ws + WS_YB)}; pg8::gemm_phase(F.lds, g, S, E); }
        }
    } SEAM(PH_S5);

    if (IN(PH_GLU)) {
        pg8::Gemm g{(const bf16*)(ws + WS_YB), (const bf16*)(ws + WS_WGLU), DM, DM, DM, 0, 0}; pg8::Order2D S; S.init(M / 256, DM / 256, F.G, bx);
        pg8::EpiGlu E{(const bf16*)(ws + WS_YB), (bf16*)(ws + WS_ZB)}; pg8::gemm_phase(F.lds, g, S, E); } SEAM(PH_GLU);

    if (IN(PH_WOUT)) {
        pg8::Gemm g{(const bf16*)(ws + WS_ZB), (const bf16*)(ws + WS_WOUT), DM, DM, DM, 0, 0}; pg8::Order2D S; S.init(M / 256, DM / 256, F.G, bx);
        pg8::EpiResid<0> E{KIN(I_X), args.out, XB, ST, DBG_S5}; pg8::gemm_phase(F.lds, g, S, E); } SEAM(PH_WOUT);

    if (IN(PH_FGU)) {
        pg8::Gemm g{XB, (const bf16*)(ws + WS_WGU), DM, DM, DM, 0, 0}; pg8::Order2D S; S.init(M / 256, NGU / 256, F.G, bx);
        pg8::build_rs_table<16>(F.lds, ST, S, 1.0f / DM); pg8::EpiSwiglu E{F.lds, (bf16*)(ws + WS_HB), DFF, 0, 1, 0}; pg8::gemm_phase(F.lds, g, S, E); } SEAM(PH_FGU);

    if (IN(PH_FDN)) {
        pg8::Gemm g{(const bf16*)(ws + WS_HB), (const bf16*)(ws + WS_WDOWN), DFF, DFF, DFF, 0, 0}; pg8::Order2D S; S.init(M / 256, DM / 256, F.G, bx);
        pg8::EpiResid<1> E{nullptr, args.out, XB, ST, DBG_FFN}; pg8::gemm_phase(F.lds, g, S, E); } SEAM(PH_FDN);

    if (IN(PH_KVQ)) {
        pg8::Gemm g{XB, (const bf16*)(ws + WS_WKVQ), DM, DM, DM, 0, 0}; pg8::Order2D S; S.init(M / 256, 4, F.G, bx);
        pg8::build_rs_table<16>(F.lds, ST, S, 1.0f / DM); pg8::EpiKvq E{F.lds, (bf16*)(ws + WS_CKV), (bf16*)(ws + WS_CQ), (bf16*)(ws + WS_KR), (float*)(ws + WS_STKV), (float*)(ws + WS_STQ), (const float*)(ws + WS_COS), (const float*)(ws + WS_SIN)};
        pg8::gemm_phase(F.lds, g, S, E); } SEAM(PH_KVQ);

    if (IN(PH_UKVQ)) {
        { pg8::Gemm g{(const bf16*)(ws + WS_CKV), (const bf16*)(ws + WS_WUKV), KVL, KVL, KVL, 0, 0}; pg8::Order2D S; S.init(M / 256, 8, F.G, bx);
          pg8::build_rs_table<4>(F.lds, (const float*)(ws + WS_STKV), S, 1.0f / KVL); pg8::EpiUkv E{F.lds, (bf16*)(ws + WS_KN), (bf16*)(ws + WS_VB)}; pg8::gemm_phase(F.lds, g, S, E); }
        { pg8::Gemm g{(const bf16*)(ws + WS_CQ), (const bf16*)(ws + WS_WUQ), QL, QL, QL, 0, 0}; pg8::Order2D S; S.init(M / 256, 6, F.G, bx);
          pg8::build_rs_table<8>(F.lds, (const float*)(ws + WS_STQ), S, 1.0f / QL); pg8::EpiUq E{F.lds, (bf16*)(ws + WS_QN), (bf16*)(ws + WS_QR), (const float*)(ws + WS_COS), (const float*)(ws + WS_SIN)}; pg8::gemm_phase(F.lds, g, S, E); }
    } SEAM(PH_UKVQ);

    if (IN(PH_ATT)) {
        const bool conv = (F.G == 256) && ((F.vcu % 12) == 0);
        if (conv) moe_weight_convert(F, (unsigned char*)args.out, F.vcu / 12, 22);
        else {
            const bf16* QN = (const bf16*)(ws + WS_QN); const bf16* QR = (const bf16*)(ws + WS_QR); const bf16* KN = (const bf16*)(ws + WS_KN); const bf16* KR = (const bf16*)(ws + WS_KR); const bf16* VB = (const bf16*)(ws + WS_VB);
            const int NU = BATCH * NH * 16, NA = (F.G == 256) ? 234 : F.G, a = (F.G == 256) ? F.vcu - 1 - (F.vcu / 12) : F.vcu;
            bf16* Ob = (bf16*)(ws + (args.probe ? WS_ARENA + 340 * MiB : WS_QN));
            for (int i = 0;; ++i) { const int pos = (i & 1) ? NA * i + NA - 1 - a : NA * i + a; if (pos >= NU) { if (NA * i >= NU) break; else continue; }
                const int qb = 15 - (pos >> 7), bh = pos & 127;
                if (F.wave < 4) attn::attn_unit<0>(bh >> 4, bh & 15, qb, QN, QR, KN, KR, VB, Ob, F.lds); else attn::attn_unit<1>(bh >> 4, bh & 15, qb, QN, QR, KN, KR, VB, Ob, F.lds); }
        }
        if (F.G != 256) { __syncthreads(); moe_weight_convert(F, (unsigned char*)args.out, F.vcu, F.G); }
    } SEAM(PH_ATT);

    if (IN(PH_WO)) {
        pg8::Gemm g{(const bf16*)(ws + WS_QN), (const bf16*)(ws + WS_WO), DM, DM, DM, 0, 0}; pg8::Order2D S; S.init(M / 256, DM / 256, F.G, bx);
        pg8::EpiResid<3> E{nullptr, args.out, XB, ST, DBG_ATT}; pg8::gemm_phase(F.lds, g, S, E); } SEAM(PH_WO);

    if (IN(PH_ROUTE)) { p14_router(F, args); } SEAM(PH_ROUTE);
    if (IN(PH_SCAT)) { p15_scatter(F, args); } SEAM(PH_SCAT);

    {
        const int* MINFO = (const int*)(ws + WS_MINFO);
        if (IN(PH_MOE0)) {
            const int np = MINFO[8];
            pg8::Gemm g{(const bf16*)(ws + WS_HS), (const bf16*)((unsigned char*)args.out + OUT_WMGU), DM / 2, DM / 2, DM / 2, 0, (size_t)NMGU * DM}; pg8::OrderMoe S; S.init(MINFO + 16, 0, np, NMGU / 256, F.G, F.vcu);
            pg8::EpiSwigluF8 E{ws + WS_ACT, MFF, 0, 1.0f / (FS_A * FS_W)}; pg8::gemm_phase<pg8::EpiSwigluF8, pg8::OrderMoe, true>(F.lds, g, S, E); }
        SEAM(PH_MOE0);
        if (IN(PH_MOE0 + 1)) {
            const int np = MINFO[8], p1 = np < SLICE_P ? np : SLICE_P;
            pg8::Gemm g{(const bf16*)(ws + WS_ACT), (const bf16*)((unsigned char*)args.out + OUT_WMDN), MFF / 2, MFF / 2, MFF / 2, 0, (size_t)DM * MFF}; pg8::OrderMoe S; S.init(MINFO + 16, 0, p1, DM / 256, F.G, F.vcu);
            pg8::EpiPlain E{(bf16*)(ws + (args.probe ? WS_SLAB : WS_YS)), DM, args.probe ? 4095 : 0x7fffffff, 1.0f / (FS_H * FS_W)}; pg8::gemm_phase<pg8::EpiPlain, pg8::OrderMoe, true>(F.lds, g, S, E); }
        if (IN(PH_MOE0 + 2)) {
            const int np = MINFO[8];
            pg8::Gemm g{(const bf16*)(ws + WS_ACT), (const bf16*)((unsigned char*)args.out + OUT_WMDN), MFF / 2, MFF / 2, MFF / 2 / pg8::KSPLIT, 0, (size_t)DM * MFF}; pg8::OrderMoeSplit S; S.init(MINFO + 16, SLICE_P, np, F.G, F.vcu);
            pg8::EpiSlab E{(bf16*)(ws + WS_SLAB), 1.0f / (FS_H * FS_W)}; pg8::gemm_phase<pg8::EpiSlab, pg8::OrderMoeSplit, true>(F.lds, g, S, E); }
        SEAM(PH_MOE0 + 2);
    }

    if (IN(PH_FINAL)) { p_final(F, args); }
#undef IN
#undef SEAM
}

extern "C" void kernel_launch(void* const* d_in, const int* in_sizes, int n_in, void* d_out, int out_size, void* d_ws, size_t ws_size, hipStream_t stream) {
    static int grid = 0;
    if (grid == 0) {
        if (n_in != 31 || in_sizes[0] != M * DM || out_size != M * DM || ws_size < WS_END) { fprintf(stderr, "kernel_launch: unexpected shapes (n_in %d, in0 %d, out %d, ws %zu)\n", n_in, n_in > 0 ? in_sizes[0] : -1, out_size, ws_size); grid = -1; return; }
        int dev = 0, cus = 0, per_cu = 0;
        if (hipGetDevice(&dev) != hipSuccess || hipDeviceGetAttribute(&cus, hipDeviceAttributeMultiprocessorCount, dev) != hipSuccess) { grid = -1; return; }
        if (hipFuncSetAttribute((const void*)yoco_fwd, hipFuncAttributeMaxDynamicSharedMemorySize, LDS_BYTES) != hipSuccess) { fprintf(stderr, "kernel_launch: hipFuncSetAttribute failed\n"); grid = -1; return; }
        if (hipOccupancyMaxActiveBlocksPerMultiprocessor(&per_cu, (const void*)yoco_fwd, NWAVES * 64, LDS_BYTES) != hipSuccess || per_cu < 1) { fprintf(stderr, "kernel_launch: occupancy query says %d\n", per_cu); }
        (void)hipGetLastError();
        grid = cus;
    }
    if (grid < 0) return;
    if (hipMemsetAsync((char*)d_ws + WS_CTL, 0, CTL_ZERO_BYTES, stream) != hipSuccess) return;
    Args a{};
    for (int i = 0; i < 31; ++i) a.in[i] = (const float*)d_in[i];
    a.out = (float*)d_out; a.ws = (unsigned char*)d_ws;
#if defined(PROBE_DUP)
    a.ph_lo = 0; a.ph_hi = PROBE_DUP; a.breg = 0; if (PROBE_DUP > 0) hipLaunchKernelGGL(yoco_fwd, dim3(grid), dim3(NWAVES * 64), LDS_BYTES, stream, a);
    a.ph_lo = PROBE_DUP; a.ph_hi = PROBE_DUP + 1; a.probe = PROBE_MODE; a.breg = 1; hipLaunchKernelGGL(yoco_fwd, dim3(grid), dim3(NWAVES * 64), LDS_BYTES, stream, a);
    a.ph_lo = PROBE_DUP; a.ph_hi = N_PHASES; a.probe = 0; a.breg = 2; hipLaunchKernelGGL(yoco_fwd, dim3(grid), dim3(NWAVES * 64), LDS_BYTES, stream, a);
#elif MK_ONE_LAUNCH
    a.ph_lo = 0; a.ph_hi = N_PHASES;
    hipLaunchKernelGGL(yoco_fwd, dim3(grid), dim3(NWAVES * 64), LDS_BYTES, stream, a);
#else
    for (int p = 0; p < N_PHASES; ++p) { a.ph_lo = p; a.ph_hi = p + 1; hipLaunchKernelGGL(yoco_fwd, dim3(grid), dim3(NWAVES * 64), LDS_BYTES, stream, a); }
#endif
}
```

```cpp
#include <hip/hip_runtime.h>
#include <cstdio>
#include <cstdint>

#ifndef DBG_S5
#define DBG_S5 1.0f
#endif
#ifndef DBG_FFN
#define DBG_FFN 1.0f
#endif
#ifndef DBG_ATT
#define DBG_ATT 1.0f
#endif
#ifndef DBG_MOE
#define DBG_MOE 1.0f
#endif
#ifndef DBG_DIAG
#define DBG_DIAG 0
#endif
#ifndef PROBE_MODE
#define PROBE_MODE 1
#endif
#ifndef MK_ONE_LAUNCH
#define MK_ONE_LAUNCH 1
#endif

#define GAS __attribute__((address_space(1)))
#define LAS __attribute__((address_space(3)))
typedef unsigned short bf16;
typedef short bf16x8 __attribute__((ext_vector_type(8)));
typedef short s16x4 __attribute__((ext_vector_type(4)));
typedef float f32x2 __attribute__((ext_vector_type(2)));
typedef float f32x4 __attribute__((ext_vector_type(4)));
typedef float f32x16 __attribute__((ext_vector_type(16)));
typedef unsigned u32x2 __attribute__((ext_vector_type(2)));
typedef unsigned u32x4 __attribute__((ext_vector_type(4)));
typedef GAS unsigned gu32;

constexpr int BATCH = 8, SEQ = 4096, DM = 1024, M = BATCH * SEQ;
constexpr int SG = 64, SGC = 16, SP = 64;
constexpr int TCH = 32, NCH = SEQ / TCH, BC = BATCH * NCH;
constexpr int UK = TCH * SGC, UGLD = UK + 2 * SP;
constexpr int DFF = 2688, NGU = 2 * DFF;
constexpr int NH = 16, DNOPE = 64, DROPE = 32, DV = 64, QL = 512, KVL = 256;
constexpr int NE = 8, MFF = 3584, NMGU = 2 * MFF;
constexpr int MAXPANEL = 264;
constexpr int SLICE_P = 256, NSLICE = 2;
constexpr float FS_A = 16.f, FS_W = 64.f, FS_H = 8.f;
constexpr float EPS = 1e-6f;
constexpr float QSCALE = 0.10206207261596575f * 1.4426950408889634f;

constexpr size_t MiB = 1u << 20;
constexpr size_t WS_CTL = 0, CTL_ZERO_BYTES = 1 * MiB;
constexpr size_t WS_ST = 1 * MiB;
constexpr size_t WS_STKV = 3 * MiB;
constexpr size_t WS_STQ = 3 * MiB + 512 * 1024;
constexpr size_t WS_COS = 5 * MiB, WS_SIN = 7 * MiB;
constexpr size_t WS_TOK = 9 * MiB;
constexpr size_t WS_POS = 9 * MiB + 512 * 1024;
constexpr size_t WS_CNT = 9 * MiB + 768 * 1024;
constexpr size_t WS_MINFO = 9 * MiB + 896 * 1024;
constexpr size_t WS_ROUTW = 10 * MiB + 128 * 1024;
constexpr size_t WS_A32 = 10 * MiB + 64 * 1024;
constexpr size_t WS_KR = 11 * MiB;
constexpr size_t WS_WIN = 16 * MiB, WS_WGLU = 18 * MiB, WS_WOUT = 20 * MiB, WS_WGU = 22 * MiB, WS_WDOWN = 33 * MiB, WS_WKVQ = 39 * MiB, WS_WUKV = 41 * MiB, WS_WUQ = 42 * MiB, WS_WO = 44 * MiB;
constexpr size_t WS_ARENA = 48 * MiB;
constexpr size_t WS_BT4 = WS_ARENA;
constexpr size_t WS_WEND = WS_ARENA + 40 * MiB;
constexpr size_t WS_UG = WS_ARENA + 56 * MiB;
constexpr size_t WS_E = WS_ARENA + 136 * MiB;
constexpr size_t WS_YB = WS_ARENA + 168 * MiB;
constexpr size_t WS_ZB = WS_ARENA + 232 * MiB;
constexpr size_t WS_HB = WS_ARENA;
constexpr size_t WS_KN = WS_ARENA + 84 * MiB;
constexpr size_t WS_VB = WS_ARENA + 148 * MiB;
constexpr size_t WS_QN = WS_ARENA + 212 * MiB;
constexpr size_t WS_QR = WS_ARENA + 276 * MiB;
constexpr size_t WS_CKV = WS_ARENA + 308 * MiB;
constexpr size_t WS_CQ = WS_ARENA + 324 * MiB;
constexpr size_t OUT_WMGU = 0;
constexpr size_t WS_SLAB = WS_ARENA + 364 * MiB;
constexpr size_t OUT_WMDN = 56 * MiB;
constexpr size_t WS_HS = WS_ARENA;
constexpr size_t WS_YS = WS_ARENA;
constexpr size_t WS_ACT = WS_ARENA + 132 * MiB;
constexpr size_t WS_XB = 448 * MiB;
constexpr size_t WS_END = 512 * MiB;
static_assert(WS_ACT + (size_t)MAXPANEL * 256 * MFF <= WS_SLAB && WS_YS + (size_t)MAXPANEL * 256 * DM * 2 <= WS_ACT && WS_SLAB + (size_t)7 * 2048 * DM * 2 <= WS_XB && OUT_WMDN + (size_t)NE * DM * MFF <= (size_t)M * DM * 4 && WS_CQ + (size_t)M * 512 * 2 <= WS_XB && WS_ZB + (size_t)M * DM * 2 <= WS_XB, "ws map");
constexpr int CW_TMO = 0, CW_BAR = 4096;

__device__ __forceinline__ unsigned cvt_pk_bf16(float lo, float hi) { unsigned r; asm volatile("v_cvt_pk_bf16_f32 %0, %1, %2" : "=v"(r) : "v"(lo), "v"(hi)); return r; }
__device__ __forceinline__ float bf2f(unsigned short b) { return __builtin_bit_cast(float, (unsigned)b << 16); }
__device__ __forceinline__ float u2f(unsigned u) { return __builtin_bit_cast(float, u); }
__device__ __forceinline__ float bflo(unsigned w) { return __builtin_bit_cast(float, w << 16); }
__device__ __forceinline__ float bfhi(unsigned w) { return __builtin_bit_cast(float, w & 0xffff0000u); }
__device__ __forceinline__ u32x4 pack8(f32x4 a, f32x4 b) { u32x4 w; w.x = cvt_pk_bf16(a[0], a[1]); w.y = cvt_pk_bf16(a[2], a[3]); w.z = cvt_pk_bf16(b[0], b[1]); w.w = cvt_pk_bf16(b[2], b[3]); return w; }
__device__ __forceinline__ unsigned pack4_fp8(f32x4 v) {
    int w = 0; w = __builtin_amdgcn_cvt_pk_fp8_f32(__builtin_amdgcn_fmed3f(v[0], -448.f, 448.f), __builtin_amdgcn_fmed3f(v[1], -448.f, 448.f), w, false);
    w = __builtin_amdgcn_cvt_pk_fp8_f32(__builtin_amdgcn_fmed3f(v[2], -448.f, 448.f), __builtin_amdgcn_fmed3f(v[3], -448.f, 448.f), w, true); return (unsigned)w;
}
__device__ __forceinline__ float fast_exp2(float x) { return __builtin_amdgcn_exp2f(x); }
__device__ __forceinline__ float fast_rcp(float x) { return __builtin_amdgcn_rcpf(x); }
__device__ __forceinline__ float sigmoid_f(float x) { return fast_rcp(1.0f + fast_exp2(-1.4426950408889634f * x)); }
__device__ __forceinline__ float silu_f(float x) { return x * sigmoid_f(x); }
__device__ __forceinline__ float gelu_tanh_f(float x) { const float z = 0.7978845608028654f * (x + 0.044715f * x * x * x); return x * sigmoid_f(2.0f * z); }
__device__ __forceinline__ float wave_sum(float v) {
#pragma unroll
    for (int o = 1; o < 64; o <<= 1) v += __shfl_xor(v, o);
    return v;
}
#define LDS_WAIT() asm volatile("s_waitcnt lgkmcnt(0)" ::: "memory")
#define VM_WAIT() asm volatile("s_waitcnt vmcnt(0)" ::: "memory")

namespace pg8 {
constexpr int BM = 256, BK = 64, HALF = 128, HTB = HALF * BK * 2, STAGE_BYTES = 8 * HTB;
__host__ __device__ __forceinline__ int lds_byte(int r, int c) { const int st = (r >> 4) * 2 + (c >> 5), rr = r & 15, cc = c & 31, ob = rr * 64 + cc * 2; return st * 1024 + (ob ^ (((ob >> 9) & 1) << 5)); }
__host__ __device__ __forceinline__ void stage_rc(int b, int& R, int& C) { const int st = b / 1024, sb = b % 1024, swz = sb ^ (((sb >> 9) & 1) << 5); R = (st >> 1) * 16 + swz / 64; C = (st & 1) * 32 + (swz % 64) / 2; }
__host__ __device__ __forceinline__ int perm32(int rho) { const int n = rho >> 4, i = rho & 15; return 8 * (i >> 2) + 4 * n + (i & 3); }

struct Unit { int pm, pn, z, ord; int offA, offB; };
struct Gemm { const bf16* A; const bf16* Bt; int lda, ldb, K; size_t zA, zB; };

struct Order2D {
    int nM, nN, nwg, G, c;
    __device__ void init(int nM_, int nN_, int G_, int c_) { nM = nM_; nN = nN_; nwg = nM * nN; G = G_; c = c_; }
    __device__ bool next(int i, Unit& u) const {
        const long L = (long)i * G + c; if (L >= nwg) return false;
        int wgid = (int)L; { const int q = nwg / 8, r = nwg % 8, xcd = wgid % 8, off = wgid / 8; wgid = (xcd < r ? xcd * (q + 1) : r * (q + 1) + (xcd - r) * q) + off; }
        const int nig = 8 * nN, gid = wgid / nig, fm = gid * 8, gsz = (nM - fm) < 8 ? (nM - fm) : 8;
        u.pm = fm + ((wgid % nig) % gsz); u.pn = (wgid % nig) / gsz; u.z = 0; u.ord = i; u.offA = 0; u.offB = 0; return true;
    }
    __device__ __forceinline__ void unit_sync() const {}
};
struct OrderBatch {
    int nM, nN, nZ, G, c;
    __device__ void init(int nM_, int nN_, int nZ_, int G_, int c_) { nM = nM_; nN = nN_; nZ = nZ_; G = G_; c = c_; }
    __device__ bool next(int i, Unit& u) const {
        const long L = (long)i * G + c; const int per = nM * nN; if (L >= (long)per * nZ) return false;
        const int z = (int)(L / per), r = (int)(L % per); u.z = z; u.pm = r / nN; u.pn = r % nN; u.ord = i; u.offA = 0; u.offB = 0; return true;
    }
    __device__ __forceinline__ void unit_sync() const {}
};
struct OrderMoe {
    const int* pexp; int p0, np, nN, G, c, flat;
    __device__ void init(const int* pexp_, int p0_, int p1_, int nN_, int G_, int c_, int flat_ = 0) { pexp = pexp_; p0 = p0_; np = p1_ > p0_ ? p1_ - p0_ : 0; nN = nN_; G = G_; c = c_; flat = flat_; gb_bar = nullptr; gb_x = 0; gb_st = nullptr; }
    __device__ bool next(int i, Unit& u) const {
        const long L = (long)i * G + c; if (L >= (long)np * nN) return false;
        const int l = (int)L, nig = 8 * nN, gid = l / nig, fm = gid * 8, gsz = (np - fm) < 8 ? (np - fm) : 8;
        u.pm = p0 + fm + ((l % nig) % gsz); u.pn = (l % nig) / gsz; if (flat == 1) { u.pm = p0 + (c & 7); u.pn = (c >> 3) & 3; } else if (flat == 2) { u.pm = p0; u.pn = 0; } else if (flat == 3) { u.pm = p0 + (c & 1); u.pn = (c >> 1) & 1; } else if (flat == 4) { u.pm = p0 + ((u.pm - p0) & 63); } u.z = pexp[u.pm]; u.ord = i; u.offA = 0; u.offB = 0; return true;
    }
    unsigned* gb_bar; unsigned gb_x; volatile LAS unsigned* gb_st;
    __device__ __forceinline__ void unit_sync() const;
};

struct OrderPanel {
    int z, pm, nN;
    __device__ bool next(int i, Unit& u) const { if (i >= nN) return false; u.pm = pm; u.pn = i; u.z = z; u.ord = i; u.offA = 0; u.offB = 0; return true; }
    __device__ __forceinline__ void unit_sync() const {}
};
constexpr int KSPLIT = 7;
struct OrderMoeSplit {
    const int* pexp; int p0, np, G, c;
    __device__ void init(const int* pexp_, int p0_, int p1_, int G_, int c_) { pexp = pexp_; p0 = p0_; np = p1_ > p0_ ? p1_ - p0_ : 0; G = G_; c = c_; }
    __device__ bool next(int i, Unit& u) const {
        const long L = (long)i * G + c; if (L >= (long)np * 4 * KSPLIT) return false;
        const int l = (int)L, kq = l % KSPLIT, r = l / KSPLIT; u.pn = r & 3; u.pm = p0 + (r >> 2); u.z = pexp[u.pm]; u.ord = kq; u.offA = kq * 512; u.offB = kq * 512; return true;
    }
    __device__ __forceinline__ void unit_sync() const {}
};
typedef int v8i __attribute__((ext_vector_type(8)));
typedef int v4i __attribute__((ext_vector_type(4)));
template <class Epi, class Sched, bool FP8 = false>
__device__ __forceinline__ void gemm_phase(LAS unsigned char* lds, const Gemm g, const Sched& S, const Epi& E) {
    int tid_ = threadIdx.x; asm volatile("" : "+v"(tid_));
    const int tid = tid_, wid = __builtin_amdgcn_readfirstlane(tid >> 6), lane = tid & 63, wr = wid >> 2, wc = wid & 3, fr = lane & 15, fq = lane >> 4;
    int K_ = g.K; asm volatile("" : "+s"(K_));
    const int K = K_, nt = K / BK;
    unsigned voffA[2], voffB[2];
#pragma unroll
    for (int i = 0; i < 2; ++i) { int R, C; stage_rc(tid * 16 + i * 8192, R, C); const int Rb = (R & ~31) + perm32(R & 31);
        voffA[i] = (unsigned)(R * g.lda + C) * 2u; voffB[i] = (unsigned)(Rb * g.ldb + C) * 2u; }
    const size_t kstep = (size_t)(BK * 2);
    const size_t hstepA = (size_t)HALF * g.lda * 2, hstepB = (size_t)HALF * g.ldb * 2;
    const unsigned ldsw = (unsigned)wid * 1024u;
    const int aoff = FP8 ? lds_byte(wr * 64 + fr, fq * 16) : lds_byte(wr * 64 + fr, fq * 8), boff = FP8 ? lds_byte(wc * 32 + fr, fq * 16) : lds_byte(wc * 32 + fr, fq * 8);
    const int aoff2 = lds_byte(wr * 64 + fr, fq * 16 + 8), boff2 = lds_byte(wc * 32 + fr, fq * 16 + 8);
#define PG8_SA(b, h) (((b) * 2 + (h)) * HTB)
#define PG8_SB(b, h) ((4 + (b) * 2 + (h)) * HTB)
#define PG8_STAGE(bufoff, gbase, voff) do { _Pragma("unroll") for (int _i = 0; _i < 2; ++_i) \
        __builtin_amdgcn_global_load_lds((const unsigned*)((const char*)(gbase) + (voff)[_i]), (LAS unsigned*)(lds + (bufoff) + ldsw + _i * 8192), 16, 0, 0); } while (0)
#define PG8_LD8(p1, p2) __builtin_shufflevector(*(const LAS v4i*)(p1), *(const LAS v4i*)(p2), 0, 1, 2, 3, 4, 5, 6, 7)
#define PG8_LDA8(dst, b, h) do { _Pragma("unroll") for (int m = 0; m < 4; ++m) dst##8[m] = PG8_LD8(lds + PG8_SA(b, h) + aoff + m * 2048, lds + PG8_SA(b, h) + aoff2 + m * 2048); } while (0)
#define PG8_LDB8(dst, b, h) do { _Pragma("unroll") for (int n = 0; n < 2; ++n) dst##8[n] = PG8_LD8(lds + PG8_SB(b, h) + boff + n * 2048, lds + PG8_SB(b, h) + boff2 + n * 2048); } while (0)
#define PG8_LDA(dst, b, h) do { if constexpr (FP8) { PG8_LDA8(dst, b, h); } else { _Pragma("unroll") for (int m = 0; m < 4; ++m) _Pragma("unroll") for (int k = 0; k < 2; ++k) dst[m][k] = *(const LAS bf16x8*)(lds + PG8_SA(b, h) + aoff + m * 2048 + k * 1024); } } while (0)
#define PG8_LDB(dst, b, h) do { if constexpr (FP8) { PG8_LDB8(dst, b, h); } else { _Pragma("unroll") for (int n = 0; n < 2; ++n) _Pragma("unroll") for (int k = 0; k < 2; ++k) dst[n][k] = *(const LAS bf16x8*)(lds + PG8_SB(b, h) + boff + n * 2048 + k * 1024); } } while (0)
#define PG8_V8(x) __builtin_bit_cast(v8i, (x))
#define PG8_MMA(ai, bj, At, Bt) do { __builtin_amdgcn_s_setprio(1); if constexpr (FP8) { _Pragma("unroll") for (int m = 0; m < 4; ++m) _Pragma("unroll") for (int n = 0; n < 2; ++n) \
        asm volatile("v_mfma_scale_f32_16x16x128_f8f6f4 %0, %1, %2, %0, %3, %3 op_sel_hi:[0,0,0]" : "+v"(acc[ai][bj][m][n]) : "v"(Bt##8[n]), "v"(At##8[m]), "v"(fscale)); } else { \
        _Pragma("unroll") for (int m = 0; m < 4; ++m) _Pragma("unroll") for (int n = 0; n < 2; ++n) _Pragma("unroll") for (int k = 0; k < 2; ++k) \
        acc[ai][bj][m][n] = __builtin_amdgcn_mfma_f32_16x16x32_bf16(Bt[n][k], At[m][k], acc[ai][bj][m][n], 0, 0, 0); } __builtin_amdgcn_s_setprio(0); } while (0)
#define PG8_WAIT_V(n) asm volatile("s_waitcnt vmcnt(" #n ")" ::: "memory")
#define PG8_WAIT_L(n) asm volatile("s_waitcnt lgkmcnt(" #n ")" ::: "memory")
#define PG8_BAR __builtin_amdgcn_s_barrier()
#define PG8_SCHED __builtin_amdgcn_sched_barrier(0)
    Unit cur, nxt; int ui = 0;
    if (!S.next(0, cur)) return;
    f32x4 acc[2][2][4][2];
#pragma unroll
    for (int a = 0; a < 2; ++a)
#pragma unroll
        for (int b = 0; b < 2; ++b)
#pragma unroll
            for (int m = 0; m < 4; ++m)
#pragma unroll
                for (int n = 0; n < 2; ++n) acc[a][b][m][n] = (f32x4){0.f, 0.f, 0.f, 0.f};
    bf16x8 At[FP8 ? 1 : 4][2], B0[FP8 ? 1 : 2][2], B1[FP8 ? 1 : 2][2];
    v8i At8[FP8 ? 4 : 1], B08[FP8 ? 2 : 1], B18[FP8 ? 2 : 1];
    int fscale = 0; if constexpr (FP8) { fscale = 0x7f7f7f7f; asm volatile("" : "+v"(fscale)); }
    const char* cA = (const char*)g.A + (size_t)cur.z * g.zA + (size_t)cur.pm * 2 * hstepA + cur.offA; const char* cB = (const char*)g.Bt + (size_t)cur.z * g.zB + (size_t)cur.pn * 2 * hstepB + cur.offB;
    PG8_STAGE(PG8_SB(0, 0), cB, voffB); PG8_STAGE(PG8_SB(0, 1), cB + hstepB, voffB); PG8_STAGE(PG8_SA(0, 0), cA, voffA); PG8_STAGE(PG8_SA(0, 1), cA + hstepA, voffA);
    if (wr == 1) PG8_BAR;
    PG8_WAIT_V(2); PG8_BAR;
    PG8_STAGE(PG8_SB(1, 0), cB + kstep, voffB); PG8_STAGE(PG8_SA(1, 0), cA + kstep, voffA); PG8_STAGE(PG8_SB(1, 1), cB + hstepB + kstep, voffB);
    PG8_WAIT_V(6); PG8_BAR;
    for (;;) {
        const bool has_next = S.next(ui + 1, nxt);
        const char* nA = has_next ? (const char*)g.A + (size_t)nxt.z * g.zA + (size_t)nxt.pm * 2 * hstepA + nxt.offA : cA; const char* nB = has_next ? (const char*)g.Bt + (size_t)nxt.z * g.zB + (size_t)nxt.pn * 2 * hstepB + nxt.offB : cB;
#pragma unroll 1
        for (int t = 0; t < nt; t += 2) {
            const bool last = (t == nt - 2);
            const char* a1 = cA + (size_t)(t + 1) * kstep;
            const char* a2 = last ? nA : cA + (size_t)(t + 2) * kstep; const char* b2 = last ? nB : cB + (size_t)(t + 2) * kstep;
            const char* a3 = a2 + kstep; const char* b3 = b2 + kstep;
            PG8_LDB(B0, 0, 0); PG8_LDB(B1, 0, 1); PG8_SCHED; PG8_LDA(At, 0, 0); PG8_STAGE(PG8_SA(1, 1), a1 + hstepA, voffA);
            PG8_WAIT_V(8); PG8_WAIT_L(0); PG8_BAR; PG8_MMA(0, 0, At, B0); PG8_MMA(0, 1, At, B1); PG8_BAR; PG8_SCHED;
            PG8_LDA(At, 0, 1); PG8_STAGE(PG8_SB(0, 0), b2, voffB); PG8_STAGE(PG8_SB(0, 1), b2 + hstepB, voffB); PG8_STAGE(PG8_SA(0, 0), a2, voffA);
            PG8_WAIT_V(8); PG8_WAIT_L(0); PG8_BAR; PG8_MMA(1, 0, At, B0); PG8_MMA(1, 1, At, B1); PG8_BAR; PG8_SCHED;
            PG8_LDB(B0, 1, 0); PG8_LDB(B1, 1, 1); PG8_SCHED; PG8_LDA(At, 1, 0); PG8_STAGE(PG8_SA(0, 1), a2 + hstepA, voffA);
            PG8_WAIT_V(8); PG8_WAIT_L(0); PG8_BAR; PG8_MMA(0, 0, At, B0); PG8_MMA(0, 1, At, B1); PG8_BAR; PG8_SCHED;
            PG8_LDA(At, 1, 1); PG8_STAGE(PG8_SB(1, 0), b3, voffB); PG8_STAGE(PG8_SB(1, 1), b3 + hstepB, voffB); PG8_STAGE(PG8_SA(1, 0), a3, voffA);
            PG8_WAIT_V(8); PG8_WAIT_L(0); PG8_BAR; PG8_MMA(1, 0, At, B0); PG8_MMA(1, 1, At, B1); PG8_BAR; PG8_SCHED;
        }
        if (wr == 0) PG8_BAR;
        if constexpr (FP8) asm volatile("s_nop 15\n\ts_nop 15" ::: "memory");
        { int el = threadIdx.x; asm volatile("" : "+v"(el));
          E(acc, cur, wr, wc, el & 15, (el >> 4) & 3); }
        S.unit_sync();
        if (!has_next) break;
#pragma unroll
        for (int a = 0; a < 2; ++a)
#pragma unroll
            for (int b = 0; b < 2; ++b)
#pragma unroll
                for (int m = 0; m < 4; ++m)
#pragma unroll
                    for (int n = 0; n < 2; ++n) acc[a][b][m][n] = (f32x4){0.f, 0.f, 0.f, 0.f};
        cur = nxt; cA = nA; cB = nB; ++ui;
        if (wr == 1) PG8_BAR;
    }
    PG8_WAIT_V(0);
    PG8_BAR;
#undef PG8_SA
#undef PG8_SB
#undef PG8_STAGE
#undef PG8_LDA
#undef PG8_LDB
#undef PG8_MMA
#undef PG8_V8
#undef PG8_LDA8
#undef PG8_LDB8
#undef PG8_LD8
#undef PG8_WAIT_V
#undef PG8_WAIT_L
#undef PG8_BAR
#undef PG8_SCHED
}

typedef const f32x4 (&Acc)[2][2][4][2];
#define EPI_ARGS Acc acc, const Unit& u, int wr, int wc, int fr, int fq
#define FOR_ROWS _Pragma("unroll") for (int ai = 0; ai < 2; ++ai) _Pragma("unroll") for (int m = 0; m < 4; ++m)
#define ROW_OF (u.pm * 256 + ai * 128 + wr * 64 + m * 16 + fr)

constexpr int RSL_OFF = 131072, RSL_MAX_UNITS = 15;
template <int NP, class Sched> __device__ __forceinline__ void build_rs_table(LAS unsigned char* lds, const float* st, const Sched& S, float invC) {
    LAS float* RSL = (LAS float*)(lds + RSL_OFF); const int t = threadIdx.x, r = t & 255;
    for (int i = t >> 8; i < RSL_MAX_UNITS; i += 2) { Unit u; if (!S.next(i, u)) break; const size_t row = (size_t)u.pm * 256 + r; float s = 0.f;
#pragma unroll
        for (int q = 0; q < NP / 4; ++q) { const f32x4 v = *(const f32x4*)(st + row * NP + 4 * q); s += (v[0] + v[1]) + (v[2] + v[3]); }
        RSL[i * 256 + r] = rsqrtf(s * invC + EPS); }
    __syncthreads();
}
__device__ __forceinline__ const LAS float* rs_base(LAS unsigned char* lds, const Unit& u, int wr, int fr) { int o = (u.ord * 256 + wr * 64 + fr) * 4 + RSL_OFF; asm volatile("" : "+v"(o)); return (const LAS float*)(lds + o); }
#define RS_OF(lds) (rsb[ai * 128 + m * 16])
__device__ __forceinline__ float sumsq8(f32x4 a, f32x4 b) { return (a[0] * a[0] + a[1] * a[1]) + (a[2] * a[2] + a[3] * a[3]) + (b[0] * b[0] + b[1] * b[1]) + (b[2] * b[2] + b[3] * b[3]); }

struct EpiUin { LAS unsigned char* lds; bf16* UG;
    __device__ __forceinline__ void operator()(EPI_ARGS) const {
        const LAS float* rsb = rs_base(lds, u, wr, fr);
        FOR_ROWS { const int row = ROW_OF; const float rs = RS_OF(lds);
            const int b = row >> 12, t = row & 4095, c = t >> 5, j = t & 31;
#pragma unroll
            for (int bj = 0; bj < 2; ++bj) { const int col0 = u.pn * 256 + bj * 128 + wc * 32 + 8 * fq, gg = col0 >> 4, m0 = col0 & 15;
                *(u32x4*)(UG + ((size_t)(gg * BC + b * NCH + c)) * UGLD + j * 16 + m0) = pack8(acc[ai][bj][m][0] * rs, acc[ai][bj][m][1] * rs); } }
    }
};
struct EpiEnd { float* E;
    __device__ __forceinline__ void operator()(EPI_ARGS) const {
        FOR_ROWS { const int row = ROW_OF; float* p = E + ((size_t)u.z * BC + row) * 128 + wc * 32 + 8 * fq;
            *(f32x4*)p = acc[ai][0][m][0]; *(f32x4*)(p + 4) = acc[ai][0][m][1]; }
    }
};
struct EpiS5Y { bf16* YB;
    __device__ __forceinline__ void operator()(EPI_ARGS) const {
        FOR_ROWS { const int row = ROW_OF; const int b = row >> 7, c = row & 127;
#pragma unroll
            for (int bj = 0; bj < 2; ++bj) { const int col0 = u.pn * 256 + bj * 128 + wc * 32 + 8 * fq, i = col0 >> 4, n0 = col0 & 15;
                f32x4 v0 = acc[ai][bj][m][0], v1 = acc[ai][bj][m][1];
#pragma unroll
                for (int e = 0; e < 4; ++e) { v0[e] = gelu_tanh_f(v0[e]); v1[e] = gelu_tanh_f(v1[e]); }
                *(u32x4*)(YB + ((size_t)(b * SEQ + c * TCH + i)) * DM + u.z * 16 + n0) = pack8(v0, v1); } }
    }
};
struct EpiGlu { const bf16* YB; bf16* ZB;
    __device__ __forceinline__ void operator()(EPI_ARGS) const {
        u32x4 y[2][4][2];
        FOR_ROWS { const int row = ROW_OF;
#pragma unroll
            for (int bj = 0; bj < 2; ++bj) y[ai][m][bj] = *(const u32x4*)(YB + (size_t)row * DM + u.pn * 256 + bj * 128 + wc * 32 + 8 * fq); }
        FOR_ROWS { const int row = ROW_OF;
#pragma unroll
            for (int bj = 0; bj < 2; ++bj) { const int col0 = u.pn * 256 + bj * 128 + wc * 32 + 8 * fq; const size_t o = (size_t)row * DM + col0;
                const u32x4 yy = y[ai][m][bj]; f32x4 v0 = acc[ai][bj][m][0], v1 = acc[ai][bj][m][1];
                v0[0] = bflo(yy.x) * sigmoid_f(v0[0]); v0[1] = bfhi(yy.x) * sigmoid_f(v0[1]); v0[2] = bflo(yy.y) * sigmoid_f(v0[2]); v0[3] = bfhi(yy.y) * sigmoid_f(v0[3]);
                v1[0] = bflo(yy.z) * sigmoid_f(v1[0]); v1[1] = bfhi(yy.z) * sigmoid_f(v1[1]); v1[2] = bflo(yy.w) * sigmoid_f(v1[2]); v1[3] = bfhi(yy.w) * sigmoid_f(v1[3]);
                *(u32x4*)(ZB + o) = pack8(v0, v1); } }
    }
};
template <int MODE> struct EpiResid { const float* xin; float* XF; bf16* XB; float* st; float bs;
    __device__ __forceinline__ void operator()(EPI_ARGS) const {
#pragma unroll
        for (int ai = 0; ai < 2; ++ai) {
            f32x4 x[4][2][2];
#pragma unroll
            for (int m = 0; m < 4; ++m) { const int row = ROW_OF;
#pragma unroll
                for (int bj = 0; bj < 2; ++bj) { const size_t o = (size_t)row * DM + u.pn * 256 + bj * 128 + wc * 32 + 8 * fq;
                    if (MODE == 0) { x[m][bj][0] = *(const f32x4*)(xin + o); x[m][bj][1] = *(const f32x4*)(xin + o + 4); }
                    else { const u32x4 w = *(const u32x4*)(XB + o); x[m][bj][0] = (f32x4){bflo(w.x), bfhi(w.x), bflo(w.y), bfhi(w.y)}; x[m][bj][1] = (f32x4){bflo(w.z), bfhi(w.z), bflo(w.w), bfhi(w.w)}; } } }
#pragma unroll
            for (int m = 0; m < 4; ++m) { const int row = ROW_OF; float ss = 0.f;
#pragma unroll
                for (int bj = 0; bj < 2; ++bj) { const size_t o = (size_t)row * DM + u.pn * 256 + bj * 128 + wc * 32 + 8 * fq;
                    const f32x4 v0 = x[m][bj][0] + acc[ai][bj][m][0] * bs, v1 = x[m][bj][1] + acc[ai][bj][m][1] * bs;
                    if (MODE == 2) { *(f32x4*)(XF + o) = v0; *(f32x4*)(XF + o + 4) = v1; }
                    else { *(u32x4*)(XB + o) = pack8(v0, v1); if (MODE != 3) ss += sumsq8(v0, v1); } }
                if (MODE != 2 && MODE != 3) { ss += __shfl_xor(ss, 16); ss += __shfl_xor(ss, 32); if (fq == 0) st[(size_t)row * 16 + u.pn * 4 + wc] = ss; } }
        }
    }
};
struct EpiSwiglu { LAS unsigned char* lds; bf16* H; int ldh; int row_sub; int use_rs; int mode;
    __device__ __forceinline__ void operator()(EPI_ARGS) const {
        const LAS float* rsb = use_rs ? rs_base(lds, u, wr, fr) : (const LAS float*)lds;
        if (mode == 3) return;
        FOR_ROWS { const int row = ROW_OF; const float rs = use_rs ? RS_OF(lds) : 1.0f;
            f32x4 g0 = acc[ai][0][m][0] * rs, g1 = acc[ai][0][m][1] * rs; const f32x4 u0 = acc[ai][1][m][0] * rs, u1 = acc[ai][1][m][1] * rs;
#pragma unroll
            for (int e = 0; e < 4; ++e) { if (mode == 2) { g0[e] = g0[e] + u0[e]; g1[e] = g1[e] + u1[e]; } else { g0[e] = silu_f(g0[e]) * u0[e]; g1[e] = silu_f(g1[e]) * u1[e]; } }
            *(u32x4*)(H + (size_t)(row - row_sub) * ldh + u.pn * 128 + wc * 32 + 8 * fq) = pack8(g0, g1); }
    }
};
struct RopeTab { f32x4 cA, cB, sA, sB; };
__device__ __forceinline__ RopeTab rope_load(const float* cosb, const float* sinb, int row, int fq) {
    const int c0 = (8 * fq) & 15; RopeTab t; t.cA = *(const f32x4*)(cosb + (size_t)row * 16 + c0); t.cB = *(const f32x4*)(cosb + (size_t)row * 16 + c0 + 4);
    t.sA = *(const f32x4*)(sinb + (size_t)row * 16 + c0); t.sB = *(const f32x4*)(sinb + (size_t)row * 16 + c0 + 4); return t;
}
__device__ __forceinline__ void rope8(f32x4& v0, f32x4& v1, const RopeTab& t, int fq) {
    f32x4 p0, p1;
#pragma unroll
    for (int e = 0; e < 4; ++e) { p0[e] = __shfl_xor(v0[e], 32); p1[e] = __shfl_xor(v1[e], 32); }
    if (fq < 2) { v0 = v0 * t.cA - p0 * t.sA; v1 = v1 * t.cB - p1 * t.sB; }
    else        { v0 = v0 * t.cA + p0 * t.sA; v1 = v1 * t.cB + p1 * t.sB; }
}
struct EpiKvq { LAS unsigned char* lds; bf16* CKV; bf16* CQ; bf16* KR; float* stkv; float* stq; const float* cosb; const float* sinb;
    __device__ __forceinline__ void operator()(EPI_ARGS) const {
        const LAS float* rsb = rs_base(lds, u, wr, fr);
        if (u.pn == 3) {
            if (wc == 0) {
#pragma unroll
                for (int ai = 0; ai < 2; ++ai) { RopeTab t[4];
#pragma unroll
                    for (int m = 0; m < 4; ++m) t[m] = rope_load(cosb, sinb, ROW_OF, fq);
#pragma unroll
                    for (int m = 0; m < 4; ++m) { const int row = ROW_OF; const float rs = RS_OF(lds); f32x4 v0 = acc[ai][0][m][0] * rs, v1 = acc[ai][0][m][1] * rs;
                        rope8(v0, v1, t[m], fq); *(u32x4*)(KR + (size_t)row * 32 + 8 * fq) = pack8(v0, v1); } }
            }
            return;
        }
        FOR_ROWS { const int row = ROW_OF; const float rs = RS_OF(lds); float ss = 0.f;
#pragma unroll
            for (int bj = 0; bj < 2; ++bj) { const int cl = bj * 128 + wc * 32 + 8 * fq; const f32x4 v0 = acc[ai][bj][m][0] * rs, v1 = acc[ai][bj][m][1] * rs; ss += sumsq8(v0, v1);
                if (u.pn == 0) *(u32x4*)(CKV + (size_t)row * KVL + cl) = pack8(v0, v1); else *(u32x4*)(CQ + (size_t)row * QL + (u.pn - 1) * 256 + cl) = pack8(v0, v1); }
            ss += __shfl_xor(ss, 16); ss += __shfl_xor(ss, 32);
            if (fq == 0) { if (u.pn == 0) stkv[(size_t)row * 4 + wc] = ss; else stq[(size_t)row * 8 + (u.pn - 1) * 4 + wc] = ss; } }
    }
};
struct EpiUkv { LAS unsigned char* lds; bf16* KN; bf16* VB;
    __device__ __forceinline__ void operator()(EPI_ARGS) const {
        bf16* dst = u.pn < 4 ? KN : VB; const int ct = (u.pn & 3) * 256; const LAS float* rsb = rs_base(lds, u, wr, fr);
        FOR_ROWS { const int row = ROW_OF; const float rs = RS_OF(lds);
#pragma unroll
            for (int bj = 0; bj < 2; ++bj) *(u32x4*)(dst + (size_t)row * DM + ct + bj * 128 + wc * 32 + 8 * fq) = pack8(acc[ai][bj][m][0] * rs, acc[ai][bj][m][1] * rs); }
    }
};
struct EpiUq { LAS unsigned char* lds; bf16* QN; bf16* QR; const float* cosb; const float* sinb;
    __device__ __forceinline__ void operator()(EPI_ARGS) const {
        const LAS float* rsb = rs_base(lds, u, wr, fr);
        if (u.pn < 4) {
            FOR_ROWS { const int row = ROW_OF; const float rs = RS_OF(lds) * QSCALE;
#pragma unroll
                for (int bj = 0; bj < 2; ++bj) *(u32x4*)(QN + (size_t)row * DM + u.pn * 256 + bj * 128 + wc * 32 + 8 * fq) = pack8(acc[ai][bj][m][0] * rs, acc[ai][bj][m][1] * rs); }
            return;
        }
#pragma unroll
        for (int ai = 0; ai < 2; ++ai) { RopeTab t[4];
#pragma unroll
            for (int m = 0; m < 4; ++m) t[m] = rope_load(cosb, sinb, ROW_OF, fq);
#pragma unroll
            for (int m = 0; m < 4; ++m) { const int row = ROW_OF; const float rs = RS_OF(lds) * QSCALE;
#pragma unroll
                for (int bj = 0; bj < 2; ++bj) { f32x4 v0 = acc[ai][bj][m][0] * rs, v1 = acc[ai][bj][m][1] * rs; rope8(v0, v1, t[m], fq);
                    *(u32x4*)(QR + (size_t)row * 512 + (u.pn - 4) * 256 + bj * 128 + wc * 32 + 8 * fq) = pack8(v0, v1); } } }
    }
};
struct EpiSwigluF8 { unsigned char* H8; int ldh; int row_sub; float sc;
    __device__ __forceinline__ void operator()(EPI_ARGS) const {
#pragma unroll
        for (int ai = 0; ai < 2; ++ai)
#pragma unroll
            for (int mp = 0; mp < 4; mp += 2) { u32x2 w[2];
#pragma unroll
                for (int q = 0; q < 2; ++q) { const int m = mp + q;
                    f32x4 g0 = acc[ai][0][m][0] * sc, g1 = acc[ai][0][m][1] * sc; const f32x4 u0 = acc[ai][1][m][0] * (sc * FS_H), u1 = acc[ai][1][m][1] * (sc * FS_H);
#pragma unroll
                    for (int e = 0; e < 4; ++e) { g0[e] = silu_f(g0[e]) * u0[e]; g1[e] = silu_f(g1[e]) * u1[e]; }
                    w[q] = (u32x2){pack4_fp8(g0), pack4_fp8(g1)}; }
                const auto s0 = __builtin_amdgcn_permlane16_swap(w[0].x, w[1].x, false, false), s1 = __builtin_amdgcn_permlane16_swap(w[0].y, w[1].y, false, false);
                const int m = mp + (fq & 1), row = ROW_OF;
                *(u32x4*)(H8 + (size_t)(row - row_sub) * ldh + u.pn * 128 + wc * 32 + 16 * (fq >> 1)) = (u32x4){s0[0], s1[0], s0[1], s1[1]}; }
    }
};
struct EpiSlab { bf16* S; float sc;
    __device__ __forceinline__ void operator()(EPI_ARGS) const {
        FOR_ROWS { const int row = ROW_OF;
#pragma unroll
            for (int bj = 0; bj < 2; ++bj) *(u32x4*)(S + ((size_t)u.ord * 2048 + (row - 65536)) * DM + u.pn * 256 + bj * 128 + wc * 32 + 8 * fq) = pack8(acc[ai][bj][m][0] * sc, acc[ai][bj][m][1] * sc); }
    }
};
struct EpiPlain { bf16* O; int ldo; int rmask; float sc;
    __device__ __forceinline__ void operator()(EPI_ARGS) const {
        FOR_ROWS { const int row = ROW_OF;
#pragma unroll
            for (int bj = 0; bj < 2; ++bj) *(u32x4*)(O + (size_t)(row & rmask) * ldo + u.pn * 256 + bj * 128 + wc * 32 + 8 * fq) = pack8(acc[ai][bj][m][0] * sc, acc[ai][bj][m][1] * sc); }
    }
};
}

namespace attn {
constexpr int KSLOT = 12288, VSLOT = 8192;
constexpr int NKS = 4, NVS = 3;
constexpr int L_K = 0, L_V = NKS * KSLOT, L_WS = L_V + NVS * VSLOT, L_OST = L_WS + 8 * 64 * 4, L_BYTES = L_OST + 8 * 4096;
__device__ __forceinline__ int crow(int r, int hi) { return (r & 3) + 8 * (r >> 2) + 4 * hi; }
__device__ __forceinline__ float max3f(float a, float b, float c) { return __builtin_fmaxf(__builtin_fmaxf(a, b), c); }

__device__ __forceinline__ float xhalf_max(float m) { auto rr = __builtin_amdgcn_permlane32_swap(__float_as_uint(m), __float_as_uint(m), false, false); return __builtin_fmaxf(__uint_as_float(rr[0]), __uint_as_float(rr[1])); }
__device__ __forceinline__ float xhalf_sum(float m) { auto rr = __builtin_amdgcn_permlane32_swap(__float_as_uint(m), __float_as_uint(m), false, false); return __uint_as_float(rr[0]) + __uint_as_float(rr[1]); }
__device__ __forceinline__ float rowmax32(const f32x16& p0, const f32x16& p1) {
    float a = max3f(p0[0], p0[1], p1[0]), b = max3f(p0[2], p0[3], p1[1]); a = max3f(a, p1[2], p1[3]);
#pragma unroll
    for (int r = 4; r < 16; r += 4) { a = max3f(a, p0[r], p0[r + 1]); b = max3f(b, p0[r + 2], p0[r + 3]); a = max3f(a, p1[r], p1[r + 1]); b = max3f(b, p1[r + 2], p1[r + 3]); }
    return xhalf_max(__builtin_fmaxf(a, b));
}
template <int ORD> __device__ __forceinline__ void attn_unit(int b, int h, int qb, const bf16* QN, const bf16* QR, const bf16* KN, const bf16* KR, const bf16* VB, bf16* O, LAS unsigned char* shm) {
    int tid_ = threadIdx.x; asm volatile("" : "+v"(tid_));
    const int tid = tid_, lane = tid & 63, r32 = lane & 31, hi = lane >> 5; const int wid = __builtin_amdgcn_readfirstlane(tid >> 6);
    const long rowbase = (long)b * SEQ; const int q0 = qb * 256;
    const int NT = (q0 + 256) / 64;
    const int tmax = (q0 + 32 * wid) >> 6;
    LAS float* wsf = (LAS float*)(shm + L_WS) + wid * 64;
    const bf16* ksrc0 = KN + (rowbase + lane) * DM + h * 64 + wid * 8;
    const bf16* ksrc1 = KR + (rowbase + lane) * 32 + (wid & 3) * 8;
    const bf16* vsrc = VB + (rowbase + 16 * (wid & 3) + (lane >> 2)) * DM + h * 64 + (wid >> 2) * 32 + (lane & 3) * 8;
#define DMA_K(t, s) do { \
        __builtin_amdgcn_global_load_lds((const unsigned*)(ksrc0 + (long)(t) * 64 * DM), (LAS unsigned*)(shm + L_K + (s) * KSLOT + wid * 1024), 16, 0, 0); \
        if (wid < 4) __builtin_amdgcn_global_load_lds((const unsigned*)(ksrc1 + (long)(t) * 64 * 32), (LAS unsigned*)(shm + L_K + (s) * KSLOT + (8 + wid) * 1024), 16, 0, 0); } while (0)
#define DMA_V(t, s) __builtin_amdgcn_global_load_lds((const unsigned*)(vsrc + (long)(t) * 64 * DM), (LAS unsigned*)(shm + L_V + (s) * VSLOT + wid * 1024), 16, 0, 0)
    DMA_K(0, 0); DMA_V(0, 0); DMA_K(1, 1); DMA_K(2, 2);
    bf16x8 qr[6];
    { const long qrow = rowbase + q0 + wid * 32 + r32;
#pragma unroll
      for (int d0 = 0; d0 < 4; ++d0) qr[d0] = *(const bf16x8*)(QN + qrow * DM + h * 64 + d0 * 16 + hi * 8);
#pragma unroll
      for (int d0 = 0; d0 < 2; ++d0) qr[4 + d0] = *(const bf16x8*)(QR + qrow * 512 + h * 32 + d0 * 16 + hi * 8); }
    float mhat = 0.f, l_reg = 0.f; f32x16 o[2]; o[0] = f32x16{}; o[1] = f32x16{}; f32x16 negm = f32x16{};
    const unsigned vbase = (unsigned)(uintptr_t)(shm + L_V) + ((lane >> 4) & 1) * 32 + (lane & 3) * 8 + (4 * hi + ((lane & 15) >> 2)) * 64;
    const LAS unsigned char* kbase = shm + L_K + hi * 1024 + r32 * 16;
#define QKT(P0, P1, s) do { const LAS unsigned char* kb_ = kbase + (s) * KSLOT; \
        _Pragma("unroll") for (int d0 = 0; d0 < 6; ++d0) { const bf16x8 b0_ = *(const LAS bf16x8*)(kb_ + d0 * 2048), b1_ = *(const LAS bf16x8*)(kb_ + d0 * 2048 + 512); \
            if (d0 == 0) { P0 = __builtin_amdgcn_mfma_f32_32x32x16_bf16(b0_, qr[0], negm, 0, 0, 0); P1 = __builtin_amdgcn_mfma_f32_32x32x16_bf16(b1_, qr[0], negm, 0, 0, 0); } \
            else { P0 = __builtin_amdgcn_mfma_f32_32x32x16_bf16(b0_, qr[d0], P0, 0, 0, 0); P1 = __builtin_amdgcn_mfma_f32_32x32x16_bf16(b1_, qr[d0], P1, 0, 0, 0); } } } while (0)
#define VF(i) (bf16x8){lo[i][0], lo[i][1], lo[i][2], lo[i][3], hh[i][0], hh[i][1], hh[i][2], hh[i][3]}
#define PV(PW, tt) do { const unsigned vb = vbase + ((tt) % 3) * VSLOT; s16x4 lo[8], hh[8]; \
        _Pragma("unroll") for (int i = 0; i < 8; ++i) { \
            asm volatile("ds_read_b64_tr_b16 %0,%1 offset:%c2" : "=&v"(lo[i]) : "v"(vb), "i"((i >> 2) * 4096 + (i & 3) * 1024) : "memory"); \
            asm volatile("ds_read_b64_tr_b16 %0,%1 offset:%c2" : "=&v"(hh[i]) : "v"(vb), "i"((i >> 2) * 4096 + (i & 3) * 1024 + 512) : "memory"); } \
        asm volatile("s_waitcnt lgkmcnt(0)" : "+v"(lo[0]), "+v"(lo[1]), "+v"(lo[2]), "+v"(lo[3]), "+v"(lo[4]), "+v"(lo[5]), "+v"(lo[6]), "+v"(lo[7]), \
                     "+v"(hh[0]), "+v"(hh[1]), "+v"(hh[2]), "+v"(hh[3]), "+v"(hh[4]), "+v"(hh[5]), "+v"(hh[6]), "+v"(hh[7]) :: "memory");     \
        o[0] = __builtin_amdgcn_mfma_f32_32x32x16_bf16(__builtin_bit_cast(bf16x8, PW[0]), VF(0), o[0], 0, 0, 0); o[1] = __builtin_amdgcn_mfma_f32_32x32x16_bf16(__builtin_bit_cast(bf16x8, PW[0]), VF(4), o[1], 0, 0, 0); \
        o[0] = __builtin_amdgcn_mfma_f32_32x32x16_bf16(__builtin_bit_cast(bf16x8, PW[1]), VF(1), o[0], 0, 0, 0); o[1] = __builtin_amdgcn_mfma_f32_32x32x16_bf16(__builtin_bit_cast(bf16x8, PW[1]), VF(5), o[1], 0, 0, 0); \
        o[0] = __builtin_amdgcn_mfma_f32_32x32x16_bf16(__builtin_bit_cast(bf16x8, PW[2]), VF(2), o[0], 0, 0, 0); o[1] = __builtin_amdgcn_mfma_f32_32x32x16_bf16(__builtin_bit_cast(bf16x8, PW[2]), VF(6), o[1], 0, 0, 0); \
        o[0] = __builtin_amdgcn_mfma_f32_32x32x16_bf16(__builtin_bit_cast(bf16x8, PW[3]), VF(3), o[0], 0, 0, 0); o[1] = __builtin_amdgcn_mfma_f32_32x32x16_bf16(__builtin_bit_cast(bf16x8, PW[3]), VF(7), o[1], 0, 0, 0); } while (0)
#define OSCALE() do { LDS_WAIT(); _Pragma("unroll") for (int d = 0; d < 2; ++d) _Pragma("unroll") for (int r = 0; r < 16; ++r) o[d][r] *= wsf[crow(r, hi)]; } while (0)
#define MBLOCK(N0, N1, PWP, t, ORD) do { \
        if ((t) >= 1 && (t) - 1 <= tmax) PV(PWP, (t) - 1); \
        if ((ORD) == 1 && resc) OSCALE(); \
        if (nx) QKT(N0, N1, ((t) + 1) & 3); } while (0)
#define VBLOCK(C0, C1, N0, N1, PWN, t, ORD) do { \
        const float rm = rowmax32(C0, C1); \
        if ((t) == 0 || __any(rm > 8.0f)) { \
            const float dl = (t) == 0 ? rm : __builtin_fmaxf(rm, 0.f); mhat += dl; \
            _Pragma("unroll") for (int r = 0; r < 16; ++r) { C0[r] -= dl; C1[r] -= dl; negm[r] = -mhat; } \
            if ((ORD) == 0 && nx) { _Pragma("unroll") for (int r = 0; r < 16; ++r) { N0[r] -= dl; N1[r] -= dl; } }     \
            const float f = fast_exp2(-dl); l_reg *= f; \
            if ((t) != 0) { if (hi == 0) wsf[r32] = f; if ((ORD) == 0) OSCALE(); else resc = true; } } \
        float sacc = 0.f; \
        _Pragma("unroll") for (int r = 0; r < 16; ++r) { C0[r] = fast_exp2(C0[r]); C1[r] = fast_exp2(C1[r]); sacc += C0[r] + C1[r]; } \
        l_reg += sacc; \
        PWN[0] = (u32x4){cvt_pk_bf16(C0[0], C0[1]), cvt_pk_bf16(C0[2], C0[3]), cvt_pk_bf16(C0[4], C0[5]), cvt_pk_bf16(C0[6], C0[7])}; \
        PWN[1] = (u32x4){cvt_pk_bf16(C0[8], C0[9]), cvt_pk_bf16(C0[10], C0[11]), cvt_pk_bf16(C0[12], C0[13]), cvt_pk_bf16(C0[14], C0[15])}; \
        PWN[2] = (u32x4){cvt_pk_bf16(C1[0], C1[1]), cvt_pk_bf16(C1[2], C1[3]), cvt_pk_bf16(C1[4], C1[5]), cvt_pk_bf16(C1[6], C1[7])}; \
        PWN[3] = (u32x4){cvt_pk_bf16(C1[8], C1[9]), cvt_pk_bf16(C1[10], C1[11]), cvt_pk_bf16(C1[12], C1[13]), cvt_pk_bf16(C1[14], C1[15])}; } while (0)
#define STEP(C0, C1, N0, N1, PWP, PWN, t, ORD) do { \
        if ((t) + 2 < NT) asm volatile("s_waitcnt vmcnt(2) lgkmcnt(0)\n\ts_barrier" ::: "memory");     \
        else asm volatile("s_waitcnt vmcnt(1) lgkmcnt(0)\n\ts_barrier" ::: "memory"); \
        if ((t) + 3 < NT) DMA_K((t) + 3, ((t) + 3) & 3); \
        if ((t) + 1 < NT) DMA_V((t) + 1, ((t) + 1) % 3); \
        const bool nx = ((t) + 1 <= tmax) && ((t) + 1 < NT); bool resc = false; \
        if ((ORD) == 0) { MBLOCK(N0, N1, PWP, t, 0); if ((t) <= tmax) VBLOCK(C0, C1, N0, N1, PWN, t, 0); } \
        else { if ((t) <= tmax) VBLOCK(C0, C1, N0, N1, PWN, t, 1); MBLOCK(N0, N1, PWP, t, 1); } } while (0)
    f32x16 pA0, pA1, pB0, pB1; u32x4 pwX[4], pwY[4];
    asm volatile("s_waitcnt vmcnt(0) lgkmcnt(0)\n\ts_barrier" ::: "memory");
    QKT(pA0, pA1, 0);
    for (int t = 0; t < NT; t += 2) { STEP(pA0, pA1, pB0, pB1, pwY, pwX, t, ORD); STEP(pB0, pB1, pA0, pA1, pwX, pwY, t + 1, ORD); }
    asm volatile("s_waitcnt vmcnt(0) lgkmcnt(0)\n\ts_barrier" ::: "memory");
    if (tmax >= NT - 1) PV(pwY, NT - 1);
#undef STEP
#undef VBLOCK
#undef MBLOCK
#undef OSCALE
#undef PV
#undef VF
#undef QKT
    l_reg = xhalf_sum(l_reg);
    if (hi == 0) wsf[32 + r32] = l_reg; LDS_WAIT();
    bf16* Ow = O + (rowbase + q0 + wid * 32) * DM + h * 64;
    { LAS bf16* stg = (LAS bf16*)(shm + L_OST) + wid * 2048;
#pragma unroll
      for (int r = 0; r < 16; ++r) { const int orow = crow(r, hi); const float rl = fast_rcp(wsf[32 + orow]);
#pragma unroll
          for (int d0 = 0; d0 < 2; ++d0) stg[orow * 64 + d0 * 32 + r32] = (bf16)(cvt_pk_bf16(o[d0][r] * rl, 0.f) & 0xffffu); }
      LDS_WAIT();
#pragma unroll
      for (int i = 0; i < 4; ++i) { const int row = i * 8 + (lane >> 3), ch = lane & 7; const u32x4 v = *(const LAS u32x4*)(stg + row * 64 + ch * 8); *(u32x4*)(Ow + (long)row * DM + ch * 8) = v; } }
    asm volatile("s_waitcnt lgkmcnt(0)\n\ts_barrier" ::: "memory");
#undef DMA_K
#undef DMA_V
}
}

#define XB_TMO      128
#define XB_XCNT(j)  (256  + 64 * (j))
#define XB_XSUB(j)  (1280 + 64 * (j))
#define XB_XGEN(j)  (2304 + 64 * (j))
#define XB_TOP      3328
#define XB_TOPGEN   3392
#define XCD_BAR_WORDS 3456
#define XB_SPIN_CAP (1u << 22)
__device__ __forceinline__ unsigned xb_ld(unsigned* p)              { return __hip_atomic_load(p, __ATOMIC_RELAXED, __HIP_MEMORY_SCOPE_AGENT); }
__device__ __forceinline__ unsigned xb_add(unsigned* p, unsigned v) { return __hip_atomic_fetch_add(p, v, __ATOMIC_RELAXED, __HIP_MEMORY_SCOPE_AGENT); }
__device__ __forceinline__ unsigned xb_xcc_id() { return (unsigned)__builtin_amdgcn_s_getreg((3 << 11) | 20) & 0xFu; }
#define XB_SPIN(cond, bar) do { unsigned _sp = 0; while (cond) { __builtin_amdgcn_s_sleep(1); \
    if ((++_sp & 255u) == 0u) { if (xb_ld(&(bar)[XB_TMO])) break; if (_sp > XB_SPIN_CAP) { atomicAdd(&(bar)[XB_TMO], 1u); break; } } } } while (0)
struct XcdBarrier { unsigned* bar; unsigned x; volatile LAS unsigned* st; };
__device__ __forceinline__ XcdBarrier xcd_barrier_post(unsigned* bar, volatile LAS unsigned* st) {
    XcdBarrier b; b.bar = bar; b.x = xb_xcc_id(); b.st = st;
    if (threadIdx.x == 0) (void)xb_add(&bar[XB_XCNT(b.x)], 1u);
    return b;
}
__device__ __forceinline__ void xcd_barrier_complete(unsigned* bar, unsigned x, unsigned& nloc, unsigned& nx) {
    const unsigned G = gridDim.x * gridDim.y * gridDim.z;
    unsigned sum, cnt, mine, sp = 0u;
    for (;;) {
        sum = 0u; cnt = 0u; mine = 0u;
#pragma unroll
        for (unsigned j = 0; j < 16; ++j) { const unsigned c = xb_ld(&bar[XB_XCNT(j)]); sum += c; cnt += (c > 0u) ? 1u : 0u; mine = (j == x) ? c : mine; }
        if (sum == G) break;
        __builtin_amdgcn_s_sleep(1);
        if ((++sp & 255u) == 0u) { if (xb_ld(&bar[XB_TMO])) break; if (sp > XB_SPIN_CAP) { atomicAdd(&bar[XB_TMO], 1u); break; } }
    }
    nloc = mine > 0u ? mine : 1u; nx = cnt > 0u ? cnt : 1u;
}
__device__ __forceinline__ void xcd_barrier(const XcdBarrier& b) {
    asm volatile("s_waitcnt vmcnt(0)" ::: "memory");
    __syncthreads();
    if (threadIdx.x == 0) {
        unsigned* bar = b.bar;
        __builtin_amdgcn_s_waitcnt(0);
        unsigned nloc = b.st[0], nx = b.st[1];
        if (nloc == 0u) { xcd_barrier_complete(bar, b.x, nloc, nx); b.st[0] = nloc; b.st[1] = nx; }
        const unsigned old = xb_add(&bar[XB_XSUB(b.x)], 1u);
        const unsigned gen = old / nloc;
        if (old + 1u == (gen + 1u) * nloc) {
            __builtin_amdgcn_fence(__ATOMIC_RELEASE, "agent");
            asm volatile("s_waitcnt vmcnt(0)" ::: "memory");
            const unsigned og = xb_add(&bar[XB_TOP], 1u);
            const unsigned tg = og / nx;
            if (og + 1u == (tg + 1u) * nx) xb_add(&bar[XB_TOPGEN], 1u);
            else XB_SPIN(xb_ld(&bar[XB_TOPGEN]) == tg, bar);
            __builtin_amdgcn_fence(__ATOMIC_ACQUIRE, "agent");
            xb_add(&bar[XB_XGEN(b.x)], 1u);
            asm volatile("s_waitcnt vmcnt(0)" ::: "memory");
        } else {
            XB_SPIN(xb_ld(&bar[XB_XGEN(b.x)]) == gen, bar);
            __builtin_amdgcn_fence(__ATOMIC_ACQUIRE, "agent");
            asm volatile("s_waitcnt vmcnt(0)" ::: "memory");
        }
    }
    __syncthreads();
}

__device__ __forceinline__ void pg8::OrderMoe::unit_sync() const { if (gb_bar) { XcdBarrier b; b.bar = gb_bar; b.x = gb_x; b.st = gb_st; xcd_barrier(b); } }
constexpr int NWAVES = 8;
constexpr int RING_BYTES = 131072, LDS_BYTES = 147456, MISC_OFF = LDS_BYTES - 256;
struct Args { const float* in[31]; float* out; unsigned char* ws; int ph_lo, ph_hi, probe, breg; };
enum { I_X = 0, I_POS, I_NMIX, I_NFFN, I_NFIN, I_S5WIN, I_LRE, I_LIM, I_LDT, I_BRE, I_BIM, I_CRE, I_CIM, I_S5D, I_S5WGLU, I_S5WOUT, I_KVNORM, I_WDKV, I_KVLN, I_WUKV, I_WDQ, I_QLN, I_WUQ, I_WO,
       I_FG, I_FU, I_FD, I_ROUTER, I_MG, I_MU, I_MD };
struct Frame { LAS unsigned char* lds; int tid, lane, wave, vcu, G; unsigned char* ws; };
#define FRESH_IDS(F) do { int t_ = threadIdx.x; asm volatile("" : "+v"(t_)); (F).tid = t_; (F).lane = t_ & 63; } while (0)
__device__ __forceinline__ const float* karg_in(int i) {
    auto kp = __builtin_amdgcn_kernarg_segment_ptr(); unsigned long long v;
    asm volatile("s_load_dwordx2 %0, %1, %2\n\ts_waitcnt lgkmcnt(0)" : "=s"(v) : "s"(kp), "i"(i * 8));
    return (const float*)v;
}
#define KIN(i) karg_in(i)

__device__ __forceinline__ void tr_block64(const float* W, int ldw, int k0, int n0, int nvalid, const float* gain, bf16* WT, int ldt, int dr0, int dr1, LAS float* scr, int lane) {
    const int r = lane >> 4, c4 = lane & 15; f32x4 v[16];
    const bool ok = 4 * c4 < nvalid;
#pragma unroll
    for (int i = 0; i < 16; ++i) v[i] = ok ? *(const f32x4*)(W + (size_t)(k0 + 4 * i + r) * ldw + n0 + 4 * c4) : (f32x4){0.f, 0.f, 0.f, 0.f};
    if (gain) {
#pragma unroll
        for (int i = 0; i < 16; ++i) v[i] = v[i] * gain[k0 + 4 * i + r]; }
#pragma unroll
    for (int i = 0; i < 16; ++i) { LAS float* d = scr + (4 * i + r) * 65 + 4 * c4; d[0] = v[i][0]; d[1] = v[i][1]; d[2] = v[i][2]; d[3] = v[i][3]; }
    LDS_WAIT(); asm volatile("" ::: "memory");
    const int kc = lane & 7, nr = lane >> 3;
#pragma unroll
    for (int j = 0; j < 8; ++j) { const int n = 8 * j + nr; const LAS float* s = scr + (8 * kc) * 65 + n;
        u32x4 o; o.x = cvt_pk_bf16(s[0 * 65], s[1 * 65]); o.y = cvt_pk_bf16(s[2 * 65], s[3 * 65]); o.z = cvt_pk_bf16(s[4 * 65], s[5 * 65]); o.w = cvt_pk_bf16(s[6 * 65], s[7 * 65]);
        if (n < nvalid) *(u32x4*)(WT + (size_t)(n < 32 ? dr0 + n : dr1 + n - 32) * ldt + k0 + 8 * kc) = o; }
    LDS_WAIT(); asm volatile("" ::: "memory");
}
__device__ __forceinline__ void tr_block64_f8(const float* W, int ldw, int k0, int n0, const float* gain, float scale, unsigned char* WT8, int ldt, int dr0, int dr1, LAS float* scr, int lane) {
    const int r = lane >> 4, c4 = lane & 15; f32x4 v[16];
#pragma unroll
    for (int i = 0; i < 16; ++i) v[i] = *(const f32x4*)(W + (size_t)(k0 + 4 * i + r) * ldw + n0 + 4 * c4);
#pragma unroll
    for (int i = 0; i < 16; ++i) v[i] = v[i] * (gain ? gain[k0 + 4 * i + r] * scale : scale);
#pragma unroll
    for (int i = 0; i < 16; ++i) { LAS float* d = scr + (4 * i + r) * 65 + 4 * c4; d[0] = v[i][0]; d[1] = v[i][1]; d[2] = v[i][2]; d[3] = v[i][3]; }
    LDS_WAIT(); asm volatile("" ::: "memory");
    const int kc = lane & 7, nr = lane >> 3;
#pragma unroll
    for (int j = 0; j < 8; ++j) { const int n = 8 * j + nr; const LAS float* s = scr + (8 * kc) * 65 + n;
        const u32x2 o = (u32x2){pack4_fp8((f32x4){s[0 * 65], s[1 * 65], s[2 * 65], s[3 * 65]}), pack4_fp8((f32x4){s[4 * 65], s[5 * 65], s[6 * 65], s[7 * 65]})};
        *(u32x2*)(WT8 + (size_t)(n < 32 ? dr0 + n : dr1 + n - 32) * ldt + k0 + 8 * kc) = o; }
    LDS_WAIT(); asm volatile("" ::: "memory");
}
template <int MAP> __device__ __forceinline__ void tr_item_f8(const float* W, int K, int N, const float* gain, float scale, unsigned char* WT8, int ldt, int row_off, LAS float* scr, int it, int lane);
enum { MAP_PLAIN = 0, MAP_GU_GATE, MAP_GU_UP, MAP_DKV, MAP_UKV, MAP_UQ };
template <int MAP> __device__ __forceinline__ int map_row(int n0, int row_off) {
    if (MAP == MAP_PLAIN) return row_off + n0;
    if (MAP == MAP_GU_GATE) return row_off + 256 * (n0 >> 7) + (n0 & 127);
    if (MAP == MAP_GU_UP) return row_off + 256 * (n0 >> 7) + 128 + (n0 & 127);
    if (MAP == MAP_DKV) return n0 < 256 ? n0 : 768 + (n0 - 256);
    if (MAP == MAP_UKV) { const int h = n0 >> 7, w = n0 & 127; return w < 64 ? h * 64 + w : 1024 + h * 64 + (w - 64); }
    { const int h = n0 / 96, w = n0 % 96; return w < 64 ? h * 64 + w : 1024 + h * 32 + (w - 64); }
}
template <int MAP> __device__ __forceinline__ void tr_item(const float* W, int K, int N, const float* gain, bf16* WT, int ldt, int row_off, LAS float* scr, int it, int lane) {
    const int nblk = (N + 63) / 64, kb = it / nblk, nb = it % nblk, n0 = 64 * nb; const int nvalid = (N - n0) < 64 ? (N - n0) : 64;
    tr_block64(W, N, 64 * kb, n0, nvalid, gain, WT, ldt, map_row<MAP>(n0, row_off), map_row<MAP>(n0 + 32, row_off), scr, lane);
}

template <int MAP> __device__ __forceinline__ void tr_item_f8(const float* W, int K, int N, const float* gain, float scale, unsigned char* WT8, int ldt, int row_off, LAS float* scr, int it, int lane) {
    const int nblk = N / 128, kb = it / nblk, nb = it % nblk, k0 = 128 * kb, n0 = 128 * nb;
    LAS unsigned* T = (LAS unsigned*)scr; const int kr = lane >> 5, c4 = lane & 31;
#pragma unroll 1
    for (int bt = 0; bt < 4; ++bt) {
        f32x4 v[4][4];
#pragma unroll
        for (int s = 0; s < 4; ++s)
#pragma unroll
            for (int kk = 0; kk < 4; ++kk) v[s][kk] = *(const f32x4*)(W + (size_t)(k0 + 4 * (8 * bt + 2 * s + kr) + kk) * N + n0 + 4 * c4);
#pragma unroll
        for (int s = 0; s < 4; ++s) { const int kq = 8 * bt + 2 * s + kr; float gsc[4];
#pragma unroll
            for (int kk = 0; kk < 4; ++kk) gsc[kk] = gain ? gain[k0 + 4 * kq + kk] * scale : scale;
#pragma unroll
            for (int c = 0; c < 4; ++c) T[(4 * c4 + c) * 33 + kq] = pack4_fp8((f32x4){v[s][0][c] * gsc[0], v[s][1][c] * gsc[1], v[s][2][c] * gsc[2], v[s][3][c] * gsc[3]}); }
    }
    LDS_WAIT(); asm volatile("" ::: "memory");
    const int kc = lane & 7, nr = lane >> 3;
#pragma unroll
    for (int j = 0; j < 16; ++j) { const int n = 8 * j + nr; const LAS unsigned* s = T + n * 33 + 4 * kc;
        const u32x4 o = (u32x4){s[0], s[1], s[2], s[3]};
        *(u32x4*)(WT8 + (size_t)map_row<MAP>(n0 + (n & ~31), row_off) * ldt + (size_t)(n & 31) * ldt + k0 + 16 * kc) = o; }
    LDS_WAIT(); asm volatile("" ::: "memory");
}
__device__ __forceinline__ void sincos_red(double r, double& s, double& c) {
    const double r2 = r * r; double ss = 1.0, cc = 1.0;
#pragma unroll
    for (int k = 13; k >= 1; --k) { ss = 1.0 - ss * r2 * (1.0 / (double)((2 * k) * (2 * k + 1))); cc = 1.0 - cc * r2 * (1.0 / (double)((2 * k - 1) * (2 * k))); }
    s = r * ss; c = cc;
}
__device__ __forceinline__ void sincos_d(double a, double& s, double& c) {
    const double k = __builtin_rint(a * 0.15915494309189535); const double r = (a - k * 6.283185307179586) - k * 2.4492935982947064e-16;
    sincos_red(r, s, c);
}

__device__ __forceinline__ void p0_s5_tables(Frame& F, const Args& A) {
    FRESH_IDS(F);
    LAS float* L = (LAS float*)F.lds;
    constexpr int CS = 68, KS = 272;
    LAS float* AP2 = L; LAS float* BBR = L + 33 * 64 * 2; LAS float* BBI = BBR + 1024; LAS float* CR = BBI + 1024; LAS float* CI = CR + 16 * CS; LAS float* KD = CI + 16 * CS;
    bf16* BT4 = (bf16*)(F.ws + WS_BT4); bf16* WEND = (bf16*)(F.ws + WS_WEND); float* A32 = (float*)(F.ws + WS_A32);
    const int t = F.tid;
    for (int item = F.vcu; item < SG * 4; item += F.G) {
        const int g = item >> 2, q = item & 3;
        if (t < 64) {
            const int p = t; const float* bre = KIN(I_BRE) + (size_t)(g * 64 + p) * 16; const float* bim = KIN(I_BIM) + (size_t)(g * 64 + p) * 16;
            f32x4 br4[4], bi4[4];
#pragma unroll
            for (int k = 0; k < 4; ++k) { br4[k] = *(const f32x4*)(bre + 4 * k); bi4[k] = *(const f32x4*)(bim + 4 * k); }
            const double dt = exp((double)KIN(I_LDT)[g]); const double lr = (double)KIN(I_LRE)[g * 64 + p], li = (double)KIN(I_LIM)[g * 64 + p];
            const double mag = exp(lr * dt); double s1, c1; sincos_d(li * dt, s1, c1);
            const double ar = mag * c1, ai = mag * s1, den = lr * lr + li * li, nr = ar - 1.0, ni = ai;
            const double cfr = (nr * lr + ni * li) / den, cfi = (ni * lr - nr * li) / den;
            double pr = 1.0, pi = 0.0;
            for (int l = 0; l <= 32; ++l) { AP2[(l * 64 + p) * 2] = (float)pr; AP2[(l * 64 + p) * 2 + 1] = (float)pi; const double nr2 = pr * ar - pi * ai, ni2 = pr * ai + pi * ar; pr = nr2; pi = ni2; }
            if (q == 0) { A32[(g * 64 + p) * 2] = AP2[(32 * 64 + p) * 2]; A32[(g * 64 + p) * 2 + 1] = AP2[(32 * 64 + p) * 2 + 1]; }
#pragma unroll
            for (int m = 0; m < 16; ++m) { const double br = (double)br4[m >> 2][m & 3], bi = (double)bi4[m >> 2][m & 3];
                BBR[p * 16 + m] = (float)(cfr * br - cfi * bi); BBI[p * 16 + m] = (float)(cfr * bi + cfi * br); }
        }
        { const float* cre = KIN(I_CRE) + (size_t)g * 1024; const float* cim = KIN(I_CIM) + (size_t)g * 1024;
          for (int e = t; e < 1024; e += 512) { const int n = e >> 6, p = e & 63; CR[n * CS + p] = cre[e]; CI[n * CS + p] = cim[e]; } }
        __syncthreads();
        { const int lo = F.lane & 15, kk = F.lane >> 4, ph = kk >> 1, c = kk & 1;
          float P[32], Q[32], Bv[32];
#pragma unroll
          for (int s = 0; s < 32; ++s) { const int p = 2 * s + ph; const float cr = CR[lo * CS + p], ci = CI[lo * CS + p]; P[s] = c ? -ci : cr; Q[s] = c ? -cr : -ci; Bv[s] = c ? BBI[p * 16 + lo] : BBR[p * 16 + lo]; }
          f32x4 acc[4];
#pragma unroll
          for (int j = 0; j < 4; ++j) acc[j] = (f32x4){0.f, 0.f, 0.f, 0.f};
          const LAS float* apw = AP2 + (4 * F.wave * 64 + ph) * 2;
#pragma unroll
          for (int s = 0; s < 32; ++s) {
#pragma unroll
              for (int j = 0; j < 4; ++j) { const f32x2 ap = *(const LAS f32x2*)(apw + (j * 64 + 2 * s) * 2); const float a = P[s] * ap[0] + Q[s] * ap[1];
                  acc[j] = __builtin_amdgcn_mfma_f32_16x16x4f32(a, Bv[s], acc[j], 0, 0, 0); } }
          const float dsk = KIN(I_S5D)[g * 16 + lo];
#pragma unroll
          for (int j = 0; j < 4; ++j) { const int l = 4 * F.wave + j;
#pragma unroll
              for (int r = 0; r < 4; ++r) { const int n = 4 * kk + r; float v = acc[j][r]; if (l == 0 && n == lo) v += dsk; KD[l * KS + n * 16 + lo] = v; } } }
        __syncthreads();
#pragma unroll 2
        for (int piece = t; piece < 128 * 64; piece += 512) {
            const int rl = piece >> 6, pc = piece & 63, i = 8 * q + (rl >> 4), n = rl & 15, j = pc >> 1, m0 = (pc & 1) * 8, lag = i - j;
            const LAS f32x4* kp = (const LAS f32x4*)(KD + (lag < 0 ? 0 : lag) * KS + n * 16 + m0);
            f32x4 v0 = kp[0], v1 = kp[1]; if (lag < 0) { v0 = (f32x4){0.f, 0.f, 0.f, 0.f}; v1 = v0; }
            *(u32x4*)(BT4 + ((size_t)g * 512 + 128 * q + rl) * UGLD + pc * 8) = pack8(v0, v1);
        }
#pragma unroll 2
        for (int piece = t; piece < 128 * 16; piece += 512) {
            const int rl = piece >> 4, pcb = piece & 15, i = 8 * q + (rl >> 4), n = rl & 15, ri = pcb >> 3, p0 = (pcb & 7) * 8;
            const LAS f32x4* cr4 = (const LAS f32x4*)(CR + n * CS + p0); const LAS f32x4* ci4 = (const LAS f32x4*)(CI + n * CS + p0); const LAS f32x4* ap4 = (const LAS f32x4*)(AP2 + ((i + 1) * 64 + p0) * 2);
            const f32x4 c0 = cr4[0], c1 = cr4[1], d0 = ci4[0], d1 = ci4[1], a0 = ap4[0], a1 = ap4[1], a2 = ap4[2], a3 = ap4[3];
            const f32x4 ar0 = (f32x4){a0[0], a0[2], a1[0], a1[2]}, ai0 = (f32x4){a0[1], a0[3], a1[1], a1[3]}, ar1 = (f32x4){a2[0], a2[2], a3[0], a3[2]}, ai1 = (f32x4){a2[1], a2[3], a3[1], a3[3]};
            f32x4 v0, v1; if (ri == 0) { v0 = c0 * ar0 - d0 * ai0; v1 = c1 * ar1 - d1 * ai1; } else { v0 = -(c0 * ai0 + d0 * ar0); v1 = -(c1 * ai1 + d1 * ar1); }
            *(u32x4*)(BT4 + ((size_t)g * 512 + 128 * q + rl) * UGLD + 512 + pcb * 8) = pack8(v0, v1);
        }
#pragma unroll 2
        for (int piece = t; piece < 32 * 64; piece += 512) {
            const int rl = piece >> 6, pc = piece & 63, qq = 32 * q + rl, ri = qq >> 6, p = qq & 63, j = pc >> 1, m0 = (pc & 1) * 8, l = 31 - j;
            const f32x2 ap = *(const LAS f32x2*)(AP2 + (l * 64 + p) * 2); const LAS f32x4* br4 = (const LAS f32x4*)(BBR + p * 16 + m0); const LAS f32x4* bi4 = (const LAS f32x4*)(BBI + p * 16 + m0);
            const f32x4 b0 = br4[0], b1 = br4[1], e0 = bi4[0], e1 = bi4[1];
            f32x4 v0, v1; if (ri == 0) { v0 = b0 * ap[0] - e0 * ap[1]; v1 = b1 * ap[0] - e1 * ap[1]; } else { v0 = e0 * ap[0] + b0 * ap[1]; v1 = e1 * ap[0] + b1 * ap[1]; }
            *(u32x4*)(WEND + ((size_t)g * 256 + qq) * UK + pc * 8) = pack8(v0, v1);
        }
        __syncthreads();
    }
}
__device__ __forceinline__ void p0_prologue(Frame& F, const Args& A) {
    FRESH_IDS(F);
    unsigned char* ws = F.ws;
    p0_s5_tables(F, A);
    __syncthreads();
    LAS float* scr = (LAS float*)(F.lds + F.wave * 16640);
    const int gw = F.vcu * NWAVES + F.wave, NGW = F.G * NWAVES;
    constexpr int I_SQ = 16 * 16, I_FGU = 16 * 42, I_FDN = 42 * 16, I_DKV = 16 * 5, I_DQ = 16 * 8, I_UKV = 4 * 32, I_UQ = 8 * 24;
    constexpr int NIT = 3 * I_SQ + 2 * I_FGU + I_FDN + I_DKV + I_DQ + I_UKV + I_UQ + I_SQ;
    for (int it = gw; it < NIT; it += NGW) {
        int r = it;
        if (r < I_SQ) { tr_item<MAP_PLAIN>(KIN(I_S5WIN), DM, DM, KIN(I_NMIX), (bf16*)(ws + WS_WIN), DM, 0, scr, r, F.lane); continue; } r -= I_SQ;
        if (r < I_SQ) { tr_item<MAP_PLAIN>(KIN(I_S5WGLU), DM, DM, nullptr, (bf16*)(ws + WS_WGLU), DM, 0, scr, r, F.lane); continue; } r -= I_SQ;
        if (r < I_SQ) { tr_item<MAP_PLAIN>(KIN(I_S5WOUT), DM, DM, nullptr, (bf16*)(ws + WS_WOUT), DM, 0, scr, r, F.lane); continue; } r -= I_SQ;
        if (r < I_FGU) { tr_item<MAP_GU_GATE>(KIN(I_FG), DM, DFF, KIN(I_NFFN), (bf16*)(ws + WS_WGU), DM, 0, scr, r, F.lane); continue; } r -= I_FGU;
        if (r < I_FGU) { tr_item<MAP_GU_UP>(KIN(I_FU), DM, DFF, KIN(I_NFFN), (bf16*)(ws + WS_WGU), DM, 0, scr, r, F.lane); continue; } r -= I_FGU;
        if (r < I_FDN) { tr_item<MAP_PLAIN>(KIN(I_FD), DFF, DM, nullptr, (bf16*)(ws + WS_WDOWN), DFF, 0, scr, r, F.lane); continue; } r -= I_FDN;
        if (r < I_DKV) { tr_item<MAP_DKV>(KIN(I_WDKV), DM, KVL + DROPE, KIN(I_KVNORM), (bf16*)(ws + WS_WKVQ), DM, 0, scr, r, F.lane); continue; } r -= I_DKV;
        if (r < I_DQ) { tr_item<MAP_PLAIN>(KIN(I_WDQ), DM, QL, KIN(I_NMIX) + DM, (bf16*)(ws + WS_WKVQ), DM, 256, scr, r, F.lane); continue; } r -= I_DQ;
        if (r < I_UKV) { tr_item<MAP_UKV>(KIN(I_WUKV), KVL, 2048, KIN(I_KVLN), (bf16*)(ws + WS_WUKV), KVL, 0, scr, r, F.lane); continue; } r -= I_UKV;
        if (r < I_UQ) { tr_item<MAP_UQ>(KIN(I_WUQ), QL, 1536, KIN(I_QLN), (bf16*)(ws + WS_WUQ), QL, 0, scr, r, F.lane); continue; } r -= I_UQ;
        tr_item<MAP_PLAIN>(KIN(I_WO), DM, DM, nullptr, (bf16*)(ws + WS_WO), DM, 0, scr, r, F.lane);
    }
    { const float* x = KIN(I_X); bf16* XB = (bf16*)(ws + WS_XB); float* ST = (float*)(ws + WS_ST);
      for (int m0 = gw * 4; m0 < M; m0 += NGW * 4) { f32x4 v[4][4]; float s[4];
#pragma unroll
          for (int a = 0; a < 4; ++a) { const f32x4* xr = (const f32x4*)(x + (size_t)(m0 + a) * DM) + F.lane;
#pragma unroll
              for (int j = 0; j < 4; ++j) v[a][j] = xr[64 * j]; }
#pragma unroll
          for (int a = 0; a < 4; ++a) { s[a] = 0.f;
#pragma unroll
              for (int j = 0; j < 4; ++j) s[a] += (v[a][j][0] * v[a][j][0] + v[a][j][1] * v[a][j][1]) + (v[a][j][2] * v[a][j][2] + v[a][j][3] * v[a][j][3]);
              s[a] = wave_sum(s[a]); }
#pragma unroll
          for (int a = 0; a < 4; ++a) { const int m = m0 + a; u32x2* o8 = (u32x2*)(XB + (size_t)m * DM) + F.lane;
#pragma unroll
              for (int j = 0; j < 4; ++j) o8[64 * j] = (u32x2){cvt_pk_bf16(v[a][j][0], v[a][j][1]), cvt_pk_bf16(v[a][j][2], v[a][j][3])};
              if (F.lane < 16) ST[(size_t)m * 16 + F.lane] = F.lane == 0 ? s[a] : 0.f; } } }
    { const int* pos = (const int*)KIN(I_POS); float* COS = (float*)(ws + WS_COS); float* SIN = (float*)(ws + WS_SIN);
      for (int e = F.vcu * 512 + F.tid; e < M * 16; e += F.G * 512) { const int row = e >> 4, c = e & 15;
          const int c4 = c & 3, c16 = c >> 2;
          const double b4 = c4 == 0 ? 1.0 : (c4 == 1 ? 0.5623413251903491 : (c4 == 2 ? 0.31622776601683794 : 0.1778279410038923));
          const double sc = c16 == 0 ? 1.0 : (c16 == 1 ? 0.1 : (c16 == 2 ? 0.01 : 0.001));
          double s, cc; sincos_d((double)pos[row] * (b4 * sc), s, cc); COS[e] = (float)cc; SIN[e] = (float)s; } }
    { bf16* RWB = (bf16*)(ws + WS_ROUTW); const float* rw = KIN(I_ROUTER); const float* gn = KIN(I_NFFN) + DM;
      for (int e = F.vcu * 512 + F.tid; e < 32 * 64 * 8; e += F.G * 512) { const int k8 = e & 7, ln = (e >> 3) & 63, s = e >> 9, i = ln & 15, k = 32 * s + 8 * (ln >> 4) + k8;
          const float w = i < NE ? rw[k * NE + i] * gn[k] : 0.f;
          const unsigned h = cvt_pk_bf16(w, 0.f) & 0xffffu; const float r1 = w - u2f(h << 16); const unsigned m = cvt_pk_bf16(r1, 0.f) & 0xffffu; const float r2 = r1 - u2f(m << 16); const unsigned l = cvt_pk_bf16(r2, 0.f) & 0xffffu;
          RWB[e] = (bf16)h; RWB[32 * 64 * 8 + e] = (bf16)m; RWB[2 * 32 * 64 * 8 + e] = (bf16)l; } }
}

__device__ __forceinline__ void scan_panel(Frame& F, int g, int pm) {
    FRESH_IDS(F);
    const int p = F.lane, line = F.wave >> 2, seg = F.wave & 3, b = 2 * pm + line;
    const float* E = (const float*)(F.ws + WS_E); bf16* UG = (bf16*)(F.ws + WS_UG); const float* A32 = (const float*)(F.ws + WS_A32);
    LAS float* XF_ = (LAS float*)F.lds;
    const float ar = A32[(g * 64 + p) * 2], ai = A32[(g * 64 + p) * 2 + 1];
    const size_t row0 = (size_t)g * BC + b * NCH + seg * 32;
    float er[32], ei[32];
#pragma unroll
    for (int k = 0; k < 32; ++k) { er[k] = E[(row0 + k) * 128 + p]; ei[k] = E[(row0 + k) * 128 + 64 + p]; }
    float lr = 0.f, li = 0.f;
#pragma unroll
    for (int k = 0; k < 32; ++k) { const float tr = er[k], ti = ei[k]; er[k] = lr; ei[k] = li; const float nr = ar * lr - ai * li + tr, ni = ar * li + ai * lr + ti; lr = nr; li = ni; }
    XF_[((line * 4 + seg) * 2 + 0) * 64 + p] = lr; XF_[((line * 4 + seg) * 2 + 1) * 64 + p] = li;
    float sr = ar, si = ai;
#pragma unroll
    for (int q = 0; q < 5; ++q) { const float nr = sr * sr - si * si, ni = 2.f * sr * si; sr = nr; si = ni; }
    __syncthreads();
    float cr = 0.f, ci = 0.f;
    for (int k = 0; k < seg; ++k) { const float fr = XF_[((line * 4 + k) * 2 + 0) * 64 + p], fi = XF_[((line * 4 + k) * 2 + 1) * 64 + p]; const float nr = sr * cr - si * ci + fr, ni = sr * ci + si * cr + fi; cr = nr; ci = ni; }
    float pr = cr, pi = ci;
#pragma unroll
    for (int k = 0; k < 32; ++k) { bf16* d = UG + (row0 + k) * UGLD + UK; d[p] = (bf16)(cvt_pk_bf16(er[k] + pr, 0.f) & 0xffffu); d[64 + p] = (bf16)(cvt_pk_bf16(ei[k] + pi, 0.f) & 0xffffu);
        const float nr = ar * pr - ai * pi, ni = ar * pi + ai * pr; pr = nr; pi = ni; }
}

__device__ __forceinline__ void p14_router(Frame& F, const Args& A) {
    FRESH_IDS(F);
    unsigned char* ws = F.ws;
    { const u32x4* rw = (const u32x4*)(ws + WS_ROUTW); LAS u32x4* RWL = (LAS u32x4*)F.lds; for (int e = F.tid; e < 3 * 32 * 64; e += 512) RWL[e] = rw[e]; }
    __syncthreads();
    const bf16* XB = (const bf16*)(ws + WS_XB); u32x4* TOK = (u32x4*)(ws + WS_TOK); int* CNT = (int*)(ws + WS_CNT);
    const int gw = F.vcu * NWAVES + F.wave, NGW = F.G * NWAVES;
    for (int chunk = gw; chunk < M / 16; chunk += NGW) {
        f32x4 ah = (f32x4){0.f, 0.f, 0.f, 0.f}, am = ah, al = ah, as = ah;
        const bf16* xrow = XB + (size_t)(chunk * 16 + (F.lane & 15)) * DM + 8 * (F.lane >> 4); const LAS bf16x8* wl = (const LAS bf16x8*)F.lds + F.lane;
#pragma unroll 1
        for (int hf = 0; hf < 2; ++hf) {
            bf16x8 xf[16];
#pragma unroll
            for (int s = 0; s < 16; ++s) xf[s] = *(const bf16x8*)(xrow + 32 * (16 * hf + s));
#pragma unroll
            for (int s = 0; s < 16; ++s) { const int ss = 16 * hf + s;
                ah = __builtin_amdgcn_mfma_f32_16x16x32_bf16(wl[ss * 64], xf[s], ah, 0, 0, 0); am = __builtin_amdgcn_mfma_f32_16x16x32_bf16(wl[(32 + ss) * 64], xf[s], am, 0, 0, 0);
                al = __builtin_amdgcn_mfma_f32_16x16x32_bf16(wl[(64 + ss) * 64], xf[s], al, 0, 0, 0); as = __builtin_amdgcn_mfma_f32_16x16x32_bf16(xf[s], xf[s], as, 0, 0, 0); }
        }
        const int tk_ = F.lane & 15, g_ = F.lane >> 4;
        const float dg = (tk_ & 3) == 0 ? as[0] : ((tk_ & 3) == 1 ? as[1] : ((tk_ & 3) == 2 ? as[2] : as[3]));
        const float ssq = __shfl(dg, (tk_ >> 2) * 16 + tk_); const float rs = rsqrtf(ssq * (1.0f / DM) + EPS);
        float own[4], oth[4], lg[8];
#pragma unroll
        for (int r = 0; r < 4; ++r) { own[r] = ((ah[r] + am[r]) + al[r]) * rs; oth[r] = __shfl_xor(own[r], 16); }
#pragma unroll
        for (int r = 0; r < 4; ++r) { lg[r] = (g_ & 1) ? oth[r] : own[r]; lg[4 + r] = (g_ & 1) ? own[r] : oth[r]; }
        int e0 = 0; float l0 = lg[0];
#pragma unroll
        for (int e = 1; e < 8; ++e) if (lg[e] > l0) { l0 = lg[e]; e0 = e; }
        int e1 = -1; float l1 = -INFINITY;
#pragma unroll
        for (int e = 0; e < 8; ++e) if (e != e0 && lg[e] > l1) { l1 = lg[e]; e1 = e; }
        const float w1 = 1.0f / (1.0f + expf(l0 - l1)), w0 = 1.0f - w1;
        const int me0 = e0, me1 = e1; const float mw0 = w0, mw1 = w1, mrs = rs;
        int r0 = 0, r1 = 0, mycnt = 0; const bool act = F.lane < 16;
#pragma unroll
        for (int e = 0; e < 8; ++e) { const unsigned long long mk = __ballot(act && (me0 == e || me1 == e)); const int rk = __popcll(mk & ((1ull << F.lane) - 1ull));
            if (act && me0 == e) r0 = rk; if (act && me1 == e) r1 = rk; if (F.lane == e) mycnt = __popcll(mk); }
        if (act) TOK[chunk * 16 + F.lane] = (u32x4){(unsigned)me0 | ((unsigned)me1 << 8) | ((unsigned)r0 << 16) | ((unsigned)r1 << 24), __builtin_bit_cast(unsigned, mw0), __builtin_bit_cast(unsigned, mw1), __builtin_bit_cast(unsigned, mrs)};
        if (F.lane < 8) CNT[chunk * 8 + F.lane] = mycnt;
    }
}

__device__ __forceinline__ void moe_weight_convert(Frame& F, unsigned char* wm, int rank, int nconv) {
    FRESH_IDS(F);
    unsigned char* ws = F.ws;
    LAS float* scr = (LAS float*)(F.lds + F.wave * 16896);
    constexpr int I_G = 8 * 28, I_D = 28 * 8, PER_E = 2 * I_G + I_D;
    const float* gn = KIN(I_NFFN) + DM; const int gw = rank * NWAVES + F.wave, NGW = nconv * NWAVES;
    for (int it = gw; it < NE * PER_E; it += NGW) {
        const int e = it / PER_E; int r = it % PER_E;
        if (r < I_G) { tr_item_f8<MAP_GU_GATE>(KIN(I_MG) + (size_t)e * DM * MFF, DM, MFF, gn, FS_W, wm + OUT_WMGU, DM, e * NMGU, scr, r, F.lane); continue; } r -= I_G;
        if (r < I_G) { tr_item_f8<MAP_GU_UP>(KIN(I_MU) + (size_t)e * DM * MFF, DM, MFF, gn, FS_W, wm + OUT_WMGU, DM, e * NMGU, scr, r, F.lane); continue; } r -= I_G;
        tr_item_f8<MAP_PLAIN>(KIN(I_MD) + (size_t)e * MFF * DM, MFF, DM, nullptr, FS_W, wm + OUT_WMDN, MFF, e * DM, scr, r, F.lane);
    }
}

__device__ __forceinline__ void p15_scatter(Frame& F, const Args& A) {
    FRESH_IDS(F);
    unsigned char* ws = F.ws; const int* CNT = (const int*)(ws + WS_CNT); int* MINFO = (int*)(ws + WS_MINFO);
    LAS int* LI = (LAS int*)F.lds;
    if (F.tid < 32) LI[F.tid] = 0;
    __syncthreads();
    const int NCHUNK = M / 16, gw0 = F.vcu * NWAVES;
    for (int pass = 0; pass * F.G * NWAVES < NCHUNK; ++pass) {
        const int cbase = pass * F.G * NWAVES + gw0;
        __syncthreads();
        if (F.tid < 16) LI[F.tid] = 0;
        __syncthreads();
        { int tot[8], pre[8];
#pragma unroll
          for (int e = 0; e < 8; ++e) { tot[e] = 0; pre[e] = 0; }
          for (int ch = F.tid; ch < NCHUNK; ch += 512) { const int4 a = *(const int4*)(CNT + ch * 8), b = *(const int4*)(CNT + ch * 8 + 4); const int m = ch < cbase ? 1 : 0;
              tot[0] += a.x; tot[1] += a.y; tot[2] += a.z; tot[3] += a.w; tot[4] += b.x; tot[5] += b.y; tot[6] += b.z; tot[7] += b.w;
              pre[0] += m * a.x; pre[1] += m * a.y; pre[2] += m * a.z; pre[3] += m * a.w; pre[4] += m * b.x; pre[5] += m * b.y; pre[6] += m * b.z; pre[7] += m * b.w; }
#pragma unroll
          for (int e = 0; e < 8; ++e) { int v = tot[e], w = pre[e];
#pragma unroll
              for (int o = 1; o < 64; o <<= 1) { v += __shfl_xor(v, o); w += __shfl_xor(w, o); }
              if (F.lane == 0) { atomicAdd((int*)&LI[e], v); atomicAdd((int*)&LI[8 + e], w); } } }
        __syncthreads();
        if (F.tid == 0) { int s = 0; for (int e = 0; e < 8; ++e) { LI[16 + e] = s; s += (LI[e] + 255) & ~255; }
            if (F.vcu == 0 && pass == 0) { int np = 0; for (int e = 0; e < 8; ++e) { MINFO[e] = LI[16 + e]; const int pe = (LI[e] + 255) >> 8; for (int k = 0; k < pe; ++k) MINFO[16 + np + k] = e; np += pe; } MINFO[8] = np; } }
        __syncthreads();
        const int chunk = cbase + F.wave;
        if (chunk < NCHUNK) {
            int wb = 0; if (F.lane < 8) { for (int w = 0; w < F.wave; ++w) wb += CNT[(cbase + w) * 8 + F.lane]; wb += LI[8 + F.lane] + LI[16 + F.lane]; }
            const u32x4* TOK = (const u32x4*)(ws + WS_TOK); int2* POS = (int2*)(ws + WS_POS);
            u32x4 tk = (u32x4){0u, 0u, 0u, 0u}; if (F.lane < 16) tk = TOK[chunk * 16 + F.lane];
            const int e0 = tk.x & 255, e1 = (tk.x >> 8) & 255, r0 = (tk.x >> 16) & 255, r1 = (tk.x >> 24) & 255;
            const int p0 = __shfl(wb, e0) + r0, p1 = __shfl(wb, e1) + r1;
            if (F.lane < 16) POS[chunk * 16 + F.lane] = make_int2(p0, p1);
            const bf16* XB = (const bf16*)(ws + WS_XB); unsigned char* HS = ws + WS_HS;
#pragma unroll 1
            for (int t8 = 0; t8 < 16; t8 += 4) {
                u32x2 v[4][4]; int q0[4], q1[4]; float rs[4];
#pragma unroll
                for (int a = 0; a < 4; ++a) { const int tt = t8 + a, tok = chunk * 16 + tt; q0[a] = __shfl(p0, tt); q1[a] = __shfl(p1, tt); rs[a] = u2f((unsigned)__shfl((int)tk.w, tt)) * FS_A;
                    const u32x2* xr = (const u32x2*)(XB + (size_t)tok * DM) + F.lane;
#pragma unroll
                    for (int j = 0; j < 4; ++j) v[a][j] = xr[64 * j]; }
#pragma unroll
                for (int a = 0; a < 4; ++a) { unsigned* d0 = (unsigned*)(HS + (size_t)q0[a] * DM) + F.lane; unsigned* d1 = (unsigned*)(HS + (size_t)q1[a] * DM) + F.lane;
#pragma unroll
                    for (int j = 0; j < 4; ++j) { const unsigned w = pack4_fp8((f32x4){bflo(v[a][j].x), bfhi(v[a][j].x), bflo(v[a][j].y), bfhi(v[a][j].y)} * rs[a]); d0[64 * j] = w; d1[64 * j] = w; } }
            }
        }
    }
}

__device__ __forceinline__ void p_final(Frame& F, const Args& A) {
    FRESH_IDS(F);
    unsigned char* ws = F.ws; const u32x4* TOK = (const u32x4*)(ws + WS_TOK); const int2* POS = (const int2*)(ws + WS_POS); const bf16* YS = (const bf16*)(ws + WS_YS); float* XF = A.out; const bf16* XB = (const bf16*)(ws + WS_XB); const float* gf = KIN(I_NFIN);
    const int gw = F.vcu * NWAVES + F.wave, NGW = F.G * NWAVES; const bf16* SL = (const bf16*)(ws + WS_SLAB);
    for (int tok0 = gw * 2; tok0 < M; tok0 += NGW * 2) {
        u32x4 tk[2]; int2 ps[2]; u32x2 x[2][4]; u32x2 ya[2][4], yb[2][4];
#pragma unroll
        for (int a = 0; a < 2; ++a) { tk[a] = TOK[tok0 + a]; ps[a] = POS[tok0 + a]; }
#pragma unroll
        for (int a = 0; a < 2; ++a) { const u32x2* xr = (const u32x2*)(XB + (size_t)(tok0 + a) * DM) + F.lane;
            const int pa = ps[a].x < 65536 ? ps[a].x : 0, pb = ps[a].y < 65536 ? ps[a].y : 0;
            const u32x2* y0 = (const u32x2*)(YS + (size_t)pa * DM) + F.lane; const u32x2* y1 = (const u32x2*)(YS + (size_t)pb * DM) + F.lane;
#pragma unroll
            for (int j = 0; j < 4; ++j) { x[a][j] = xr[64 * j]; ya[a][j] = y0[64 * j]; yb[a][j] = y1[64 * j]; } }
#pragma unroll
        for (int a = 0; a < 2; ++a) { const int tok = tok0 + a; const float w0 = DBG_MOE * u2f(tk[a].y), w1 = DBG_MOE * u2f(tk[a].z);
            f32x4 v[4]; float ss = 0.f;
#pragma unroll
            for (int j = 0; j < 4; ++j) { f32x4 fa, fb;
                if (ps[a].x < 65536) fa = (f32x4){bflo(ya[a][j].x), bfhi(ya[a][j].x), bflo(ya[a][j].y), bfhi(ya[a][j].y)};
                else { fa = (f32x4){0.f, 0.f, 0.f, 0.f}; for (int k = 0; k < pg8::KSPLIT; ++k) { const u32x2 q = *((const u32x2*)(SL + ((size_t)k * 2048 + (ps[a].x - 65536)) * DM) + F.lane + 64 * j); fa += (f32x4){bflo(q.x), bfhi(q.x), bflo(q.y), bfhi(q.y)}; } }
                if (ps[a].y < 65536) fb = (f32x4){bflo(yb[a][j].x), bfhi(yb[a][j].x), bflo(yb[a][j].y), bfhi(yb[a][j].y)};
                else { fb = (f32x4){0.f, 0.f, 0.f, 0.f}; for (int k = 0; k < pg8::KSPLIT; ++k) { const u32x2 q = *((const u32x2*)(SL + ((size_t)k * 2048 + (ps[a].y - 65536)) * DM) + F.lane + 64 * j); fb += (f32x4){bflo(q.x), bfhi(q.x), bflo(q.y), bfhi(q.y)}; } }
                v[j] = (f32x4){bflo(x[a][j].x), bfhi(x[a][j].x), bflo(x[a][j].y), bfhi(x[a][j].y)} + w0 * fa + w1 * fb;
                ss += (v[j][0] * v[j][0] + v[j][1] * v[j][1]) + (v[j][2] * v[j][2] + v[j][3] * v[j][3]); }
            ss = wave_sum(ss); const float rs = rsqrtf(ss * (1.0f / DM) + EPS);
            f32x4* xo = (f32x4*)(XF + (size_t)tok * DM) + F.lane;
#pragma unroll
            for (int j = 0; j < 4; ++j) { const f32x4 gg = *((const f32x4*)gf + 64 * j + F.lane); xo[64 * j] = v[j] * rs * gg; } }
    }
}

constexpr int PH_PRO = 0, PH_WIN = 1, PH_S5 = 2, PH_GLU = 3, PH_WOUT = 4, PH_FGU = 5, PH_FDN = 6, PH_KVQ = 7, PH_UKVQ = 8, PH_ATT = 9, PH_WO = 10, PH_ROUTE = 11, PH_SCAT = 12,
              PH_MOE0 = 13, PH_FINAL = PH_MOE0 + 3, N_PHASES = PH_FINAL + 1;

__global__ void __launch_bounds__(NWAVES * 64, 2) yoco_fwd(Args args) {
    extern __shared__ __attribute__((aligned(16))) unsigned char lds[];
    Frame F; F.lds = (LAS unsigned char*)lds; F.tid = threadIdx.x; F.lane = F.tid & 63; F.wave = __builtin_amdgcn_readfirstlane(F.tid >> 6);
    F.G = gridDim.x; { const int bx = blockIdx.x; F.vcu = (F.G % 8 == 0) ? (bx % 8) * (F.G / 8) + bx / 8 : bx; }
    F.ws = args.ws; unsigned char* ws = args.ws;
    volatile LAS unsigned* MISC = (volatile LAS unsigned*)(F.lds + MISC_OFF);
    for (int u = F.tid; u < (LDS_BYTES - MISC_OFF) / 4; u += NWAVES * 64) ((LAS unsigned*)(F.lds + MISC_OFF))[u] = 0u;
    __syncthreads();
    const int lo = args.ph_lo, hi = args.ph_hi;
    XcdBarrier bar; bar.bar = (unsigned*)(ws + WS_CTL) + CW_BAR + args.breg * XCD_BAR_WORDS; bar.x = 0; bar.st = nullptr;
    if (hi - lo > 1 || args.probe == 13) bar = xcd_barrier_post((unsigned*)(ws + WS_CTL) + CW_BAR + args.breg * XCD_BAR_WORDS, MISC + 8);
#define IN(k) (lo <= (k) && (k) < hi)
#define SEAM(k) do { if (IN(k) && IN((k) + 1)) xcd_barrier(bar); } while (0)
    const int bx = (int)blockIdx.x;
    bf16* XB = (bf16*)(ws + WS_XB); float* ST = (float*)(ws + WS_ST);

    if (IN(PH_PRO)) { p0_prologue(F, args); __syncthreads(); } SEAM(PH_PRO);

    if (IN(PH_WIN)) {
        pg8::Gemm g{XB, (const bf16*)(ws + WS_WIN), DM, DM, DM, 0, 0}; pg8::Order2D S; S.init(M / 256, DM / 256, F.G, bx);
        pg8::build_rs_table<16>(F.lds, ST, S, 1.0f / DM); pg8::EpiUin E{F.lds, (bf16*)(ws + WS_UG)}; pg8::gemm_phase(F.lds, g, S, E); } SEAM(PH_WIN);

    if (IN(PH_S5)) {
#pragma unroll 1
        for (int item = F.vcu; item < SG * 4; item += F.G) {
            const int gq = item >> 2, pm = item & 3;
            { pg8::Gemm g{(const bf16*)(ws + WS_UG), (const bf16*)(ws + WS_WEND), UGLD, UK, UK, (size_t)BC * UGLD * 2, (size_t)256 * UK * 2}; pg8::OrderPanel S{gq, pm, 1};
              pg8::EpiEnd E{(float*)(ws + WS_E)}; pg8::gemm_phase(F.lds, g, S, E); }
            scan_panel(F, gq, pm);
            VM_WAIT(); __syncthreads();
            { pg8::Gemm g{(const bf16*)(ws + WS_UG), (const bf16*)(ws + WS_BT4), UGLD, UGLD, UGLD, (size_t)BC * UGLD * 2, (size_t)512 * UGLD * 2}; pg8::OrderPanel S{gq, pm, 2};
              pg8::EpiS5Y E{(bf16*)(ws + WS_YB)}; pg8::gemm_phase(F.lds, g, S, E); }
        }
    } SEAM(PH_S5);

    if (IN(PH_GLU)) {
        pg8::Gemm g{(const bf16*)(ws + WS_YB), (const bf16*)(ws + WS_WGLU), DM, DM, DM, 0, 0}; pg8::Order2D S; S.init(M / 256, DM / 256, F.G, bx);
        pg8::EpiGlu E{(const bf16*)(ws + WS_YB), (bf16*)(ws + WS_ZB)}; pg8::gemm_phase(F.lds, g, S, E); } SEAM(PH_GLU);

    if (IN(PH_WOUT)) {
        pg8::Gemm g{(const bf16*)(ws + WS_ZB), (const bf16*)(ws + WS_WOUT), DM, DM, DM, 0, 0}; pg8::Order2D S; S.init(M / 256, DM / 256, F.G, bx);
        pg8::EpiResid<0> E{KIN(I_X), args.out, XB, ST, DBG_S5}; pg8::gemm_phase(F.lds, g, S, E); } SEAM(PH_WOUT);

    if (IN(PH_FGU)) {
        pg8::Gemm g{XB, (const bf16*)(ws + WS_WGU), DM, DM, DM, 0, 0}; pg8::Order2D S; S.init(M / 256, NGU / 256, F.G, bx);
        pg8::build_rs_table<16>(F.lds, ST, S, 1.0f / DM); pg8::EpiSwiglu E{F.lds, (bf16*)(ws + WS_HB), DFF, 0, 1, 0}; pg8::gemm_phase(F.lds, g, S, E); } SEAM(PH_FGU);

    if (IN(PH_FDN)) {
        pg8::Gemm g{(const bf16*)(ws + WS_HB), (const bf16*)(ws + WS_WDOWN), DFF, DFF, DFF, 0, 0}; pg8::Order2D S; S.init(M / 256, DM / 256, F.G, bx);
        pg8::EpiResid<1> E{nullptr, args.out, XB, ST, DBG_FFN}; pg8::gemm_phase(F.lds, g, S, E); } SEAM(PH_FDN);

    if (IN(PH_KVQ)) {
        pg8::Gemm g{XB, (const bf16*)(ws + WS_WKVQ), DM, DM, DM, 0, 0}; pg8::Order2D S; S.init(M / 256, 4, F.G, bx);
        pg8::build_rs_table<16>(F.lds, ST, S, 1.0f / DM); pg8::EpiKvq E{F.lds, (bf16*)(ws + WS_CKV), (bf16*)(ws + WS_CQ), (bf16*)(ws + WS_KR), (float*)(ws + WS_STKV), (float*)(ws + WS_STQ), (const float*)(ws + WS_COS), (const float*)(ws + WS_SIN)};
        pg8::gemm_phase(F.lds, g, S, E); } SEAM(PH_KVQ);

    if (IN(PH_UKVQ)) {
        { pg8::Gemm g{(const bf16*)(ws + WS_CKV), (const bf16*)(ws + WS_WUKV), KVL, KVL, KVL, 0, 0}; pg8::Order2D S; S.init(M / 256, 8, F.G, bx);
          pg8::build_rs_table<4>(F.lds, (const float*)(ws + WS_STKV), S, 1.0f / KVL); pg8::EpiUkv E{F.lds, (bf16*)(ws + WS_KN), (bf16*)(ws + WS_VB)}; pg8::gemm_phase(F.lds, g, S, E); }
        { pg8::Gemm g{(const bf16*)(ws + WS_CQ), (const bf16*)(ws + WS_WUQ), QL, QL, QL, 0, 0}; pg8::Order2D S; S.init(M / 256, 6, F.G, bx);
          pg8::build_rs_table<8>(F.lds, (const float*)(ws + WS_STQ), S, 1.0f / QL); pg8::EpiUq E{F.lds, (bf16*)(ws + WS_QN), (bf16*)(ws + WS_QR), (const float*)(ws + WS_COS), (const float*)(ws + WS_SIN)}; pg8::gemm_phase(F.lds, g, S, E); }
    } SEAM(PH_UKVQ);

    if (IN(PH_ATT)) {
        const bool conv = (F.G == 256) && ((F.vcu % 12) == 0);
        if (conv) moe_weight_convert(F, (unsigned char*)args.out, F.vcu / 12, 22);
        else {
            const bf16* QN = (const bf16*)(ws + WS_QN); const bf16* QR = (const bf16*)(ws + WS_QR); const bf16* KN = (const bf16*)(ws + WS_KN); const bf16* KR = (const bf16*)(ws + WS_KR); const bf16* VB = (const bf16*)(ws + WS_VB);
            const int NU = BATCH * NH * 16, NA = (F.G == 256) ? 234 : F.G, a = (F.G == 256) ? F.vcu - 1 - (F.vcu / 12) : F.vcu;
            bf16* Ob = (bf16*)(ws + (args.probe ? WS_ARENA + 340 * MiB : WS_QN));
            for (int i = 0;; ++i) { const int pos = (i & 1) ? NA * i + NA - 1 - a : NA * i + a; if (pos >= NU) { if (NA * i >= NU) break; else continue; }
                const int qb = 15 - (pos >> 7), bh = pos & 127;
                if (F.wave < 4) attn::attn_unit<0>(bh >> 4, bh & 15, qb, QN, QR, KN, KR, VB, Ob, F.lds); else attn::attn_unit<1>(bh >> 4, bh & 15, qb, QN, QR, KN, KR, VB, Ob, F.lds); }
        }
        if (F.G != 256) { __syncthreads(); moe_weight_convert(F, (unsigned char*)args.out, F.vcu, F.G); }
    } SEAM(PH_ATT);

    if (IN(PH_WO)) {
        pg8::Gemm g{(const bf16*)(ws + WS_QN), (const bf16*)(ws + WS_WO), DM, DM, DM, 0, 0}; pg8::Order2D S; S.init(M / 256, DM / 256, F.G, bx);
        pg8::EpiResid<3> E{nullptr, args.out, XB, ST, DBG_ATT}; pg8::gemm_phase(F.lds, g, S, E); } SEAM(PH_WO);

    if (IN(PH_ROUTE)) { p14_router(F, args); } SEAM(PH_ROUTE);
    if (IN(PH_SCAT)) { p15_scatter(F, args); } SEAM(PH_SCAT);

    {
        const int* MINFO = (const int*)(ws + WS_MINFO);
        if (IN(PH_MOE0)) {
            const int np = MINFO[8];
            pg8::Gemm g{(const bf16*)(ws + WS_HS), (const bf16*)((unsigned char*)args.out + OUT_WMGU), DM / 2, DM / 2, DM / 2, 0, (size_t)NMGU * DM}; pg8::OrderMoe S; S.init(MINFO + 16, 0, np, NMGU / 256, F.G, F.vcu);
            pg8::EpiSwigluF8 E{ws + WS_ACT, MFF, 0, 1.0f / (FS_A * FS_W)}; pg8::gemm_phase<pg8::EpiSwigluF8, pg8::OrderMoe, true>(F.lds, g, S, E); }
        SEAM(PH_MOE0);
        if (IN(PH_MOE0 + 1)) {
            const int np = MINFO[8], p1 = np < SLICE_P ? np : SLICE_P;
            pg8::Gemm g{(const bf16*)(ws + WS_ACT), (const bf16*)((unsigned char*)args.out + OUT_WMDN), MFF / 2, MFF / 2, MFF / 2, 0, (size_t)DM * MFF}; pg8::OrderMoe S; S.init(MINFO + 16, 0, p1, DM / 256, F.G, F.vcu);
            pg8::EpiPlain E{(bf16*)(ws + (args.probe ? WS_SLAB : WS_YS)), DM, args.probe ? 4095 : 0x7fffffff, 1.0f / (FS_H * FS_W)}; pg8::gemm_phase<pg8::EpiPlain, pg8::OrderMoe, true>(F.lds, g, S, E); }
        SEAM(PH_MOE0 + 1);
        if (IN(PH_MOE0 + 2)) {
            const int np = MINFO[8];
            pg8::Gemm g{(const bf16*)(ws + WS_ACT), (const bf16*)((unsigned char*)args.out + OUT_WMDN), MFF / 2, MFF / 2, MFF / 2 / pg8::KSPLIT, 0, (size_t)DM * MFF}; pg8::OrderMoeSplit S; S.init(MINFO + 16, SLICE_P, np, F.G, F.vcu);
            pg8::EpiSlab E{(bf16*)(ws + WS_SLAB), 1.0f / (FS_H * FS_W)}; pg8::gemm_phase<pg8::EpiSlab, pg8::OrderMoeSplit, true>(F.lds, g, S, E); }
        SEAM(PH_MOE0 + 2);
    }

    if (IN(PH_FINAL)) { p_final(F, args); }
#undef IN
#undef SEAM
}

extern "C" void kernel_launch(void* const* d_in, const int* in_sizes, int n_in, void* d_out, int out_size, void* d_ws, size_t ws_size, hipStream_t stream) {
    static int grid = 0;
    if (grid == 0) {
        if (n_in != 31 || in_sizes[0] != M * DM || out_size != M * DM || ws_size < WS_END) { fprintf(stderr, "kernel_launch: unexpected shapes (n_in %d, in0 %d, out %d, ws %zu)\n", n_in, n_in > 0 ? in_sizes[0] : -1, out_size, ws_size); grid = -1; return; }
        int dev = 0, cus = 0, per_cu = 0;
        if (hipGetDevice(&dev) != hipSuccess || hipDeviceGetAttribute(&cus, hipDeviceAttributeMultiprocessorCount, dev) != hipSuccess) { grid = -1; return; }
        if (hipFuncSetAttribute((const void*)yoco_fwd, hipFuncAttributeMaxDynamicSharedMemorySize, LDS_BYTES) != hipSuccess) { fprintf(stderr, "kernel_launch: hipFuncSetAttribute failed\n"); grid = -1; return; }
        if (hipOccupancyMaxActiveBlocksPerMultiprocessor(&per_cu, (const void*)yoco_fwd, NWAVES * 64, LDS_BYTES) != hipSuccess || per_cu < 1) { fprintf(stderr, "kernel_launch: occupancy query says %d\n", per_cu); }
        (void)hipGetLastError();
        grid = cus;
    }
    if (grid < 0) return;
    if (hipMemsetAsync((char*)d_ws + WS_CTL, 0, CTL_ZERO_BYTES, stream) != hipSuccess) return;
    Args a{};
    for (int i = 0; i < 31; ++i) a.in[i] = (const float*)d_in[i];
    a.out = (float*)d_out; a.ws = (unsigned char*)d_ws;
#if defined(PROBE_DUP)
    a.ph_lo = 0; a.ph_hi = PROBE_DUP; a.breg = 0; if (PROBE_DUP > 0) hipLaunchKernelGGL(yoco_fwd, dim3(grid), dim3(NWAVES * 64), LDS_BYTES, stream, a);
    a.ph_lo = PROBE_DUP; a.ph_hi = PROBE_DUP + 1; a.probe = PROBE_MODE; a.breg = 1; hipLaunchKernelGGL(yoco_fwd, dim3(grid), dim3(NWAVES * 64), LDS_BYTES, stream, a);
    a.ph_lo = PROBE_DUP; a.ph_hi = N_PHASES; a.probe = 0; a.breg = 2; hipLaunchKernelGGL(yoco_fwd, dim3(grid), dim3(NWAVES * 64), LDS_BYTES, stream, a);
#elif MK_ONE_LAUNCH
    a.ph_lo = 0; a.ph_hi = N_PHASES;
    hipLaunchKernelGGL(yoco_fwd, dim3(grid), dim3(NWAVES * 64), LDS_BYTES, stream, a);
#else
    for (int p = 0; p < N_PHASES; ++p) { a.ph_lo = p; a.ph_hi = p + 1; hipLaunchKernelGGL(yoco_fwd, dim3(grid), dim3(NWAVES * 64), LDS_BYTES, stream, a); }
#endif
}
```

```cpp
#include <hip/hip_runtime.h>
#include <cstdio>
#include <cstdint>

#ifndef DBG_S5
#define DBG_S5 1.0f
#endif
#ifndef DBG_FFN
#define DBG_FFN 1.0f
#endif
#ifndef DBG_ATT
#define DBG_ATT 1.0f
#endif
#ifndef DBG_MOE
#define DBG_MOE 1.0f
#endif
#ifndef DBG_DIAG
#define DBG_DIAG 0
#endif
#ifndef PROBE_MODE
#define PROBE_MODE 1
#endif
#ifndef MK_ONE_LAUNCH
#define MK_ONE_LAUNCH 1
#endif

#define GAS __attribute__((address_space(1)))
#define LAS __attribute__((address_space(3)))
typedef unsigned short bf16;
typedef short bf16x8 __attribute__((ext_vector_type(8)));
typedef short s16x4 __attribute__((ext_vector_type(4)));
typedef float f32x2 __attribute__((ext_vector_type(2)));
typedef float f32x4 __attribute__((ext_vector_type(4)));
typedef float f32x16 __attribute__((ext_vector_type(16)));
typedef unsigned u32x2 __attribute__((ext_vector_type(2)));
typedef unsigned u32x4 __attribute__((ext_vector_type(4)));
typedef GAS unsigned gu32;

constexpr int BATCH = 8, SEQ = 4096, DM = 1024, M = BATCH * SEQ;
constexpr int SG = 64, SGC = 16, SP = 64;
constexpr int TCH = 32, NCH = SEQ / TCH, BC = BATCH * NCH;
constexpr int UK = TCH * SGC, UGLD = UK + 2 * SP, UC0 = 2 * SP;
constexpr int DFF = 2688, NGU = 2 * DFF;
constexpr int NH = 16, DNOPE = 64, DROPE = 32, DV = 64, QL = 512, KVL = 256;
constexpr int NE = 8, MFF = 3584, NMGU = 2 * MFF;
constexpr int MAXPANEL = 264;
constexpr int SLICE_P = 256, NSLICE = 2;
constexpr float FS_A = 16.f, FS_W = 64.f, FS_H = 8.f;
constexpr float EPS = 1e-6f;
constexpr float QSCALE = 0.10206207261596575f * 1.4426950408889634f;

constexpr size_t MiB = 1u << 20;
constexpr size_t WS_CTL = 0, CTL_ZERO_BYTES = 1 * MiB;
constexpr size_t WS_ST = 1 * MiB;
constexpr size_t WS_STKV = 3 * MiB;
constexpr size_t WS_STQ = 3 * MiB + 512 * 1024;
constexpr size_t WS_COS = 5 * MiB, WS_SIN = 7 * MiB;
constexpr size_t WS_TOK = 9 * MiB;
constexpr size_t WS_POS = 9 * MiB + 512 * 1024;
constexpr size_t WS_CNT = 9 * MiB + 768 * 1024;
constexpr size_t WS_MINFO = 9 * MiB + 896 * 1024;
constexpr size_t WS_ROUTW = 10 * MiB + 128 * 1024;
constexpr size_t WS_A32 = 10 * MiB + 64 * 1024;
constexpr size_t WS_KR = 11 * MiB;
constexpr size_t WS_WIN = 16 * MiB, WS_WGLU = 18 * MiB, WS_WOUT = 20 * MiB, WS_WGU = 22 * MiB, WS_WDOWN = 33 * MiB, WS_WKVQ = 39 * MiB, WS_WUKV = 41 * MiB, WS_WUQ = 42 * MiB, WS_WO = 44 * MiB;
constexpr size_t WS_ARENA = 48 * MiB;
constexpr size_t WS_BT4 = WS_ARENA;
constexpr size_t WS_WEND = WS_ARENA + 40 * MiB;
constexpr size_t WS_UG = WS_ARENA + 56 * MiB;
constexpr size_t WS_E = WS_ARENA + 136 * MiB;
constexpr size_t WS_YB = WS_ARENA + 168 * MiB;
constexpr size_t WS_ZB = WS_ARENA + 232 * MiB;
constexpr size_t WS_HB = WS_ARENA;
constexpr int H8LD = 2816;
constexpr size_t WS_KN = WS_ARENA + 84 * MiB;
constexpr size_t WS_VB = WS_ARENA + 148 * MiB;
constexpr size_t WS_QN = WS_ARENA + 212 * MiB;
constexpr size_t WS_QR = WS_ARENA + 276 * MiB;
constexpr size_t WS_CKV = WS_ARENA + 308 * MiB;
constexpr size_t WS_CQ = WS_ARENA + 324 * MiB;
constexpr size_t OUT_WMGU = 0;
constexpr size_t WS_SLAB = WS_ARENA + 364 * MiB;
constexpr size_t OUT_WMDN = 56 * MiB;
constexpr size_t WS_HS = WS_ARENA;
constexpr size_t WS_YS = WS_ARENA;
constexpr size_t WS_ACT = WS_ARENA + 132 * MiB;
constexpr size_t WS_XB = 448 * MiB;
constexpr size_t WS_END = 512 * MiB;
static_assert(WS_ACT + (size_t)MAXPANEL * 256 * MFF <= WS_SLAB && WS_YS + (size_t)MAXPANEL * 256 * DM * 2 <= WS_ACT && WS_SLAB + (size_t)7 * 2048 * DM * 2 <= WS_XB && OUT_WMDN + (size_t)NE * DM * MFF <= (size_t)M * DM * 4 && WS_CQ + (size_t)M * 512 * 2 <= WS_XB && WS_ZB + (size_t)M * DM * 2 <= WS_XB, "ws map");
constexpr int CW_TMO = 0, CW_BAR = 4096;

__device__ __forceinline__ unsigned cvt_pk_bf16(float lo, float hi) { unsigned r; asm volatile("v_cvt_pk_bf16_f32 %0, %1, %2" : "=v"(r) : "v"(lo), "v"(hi)); return r; }
__device__ __forceinline__ float bf2f(unsigned short b) { return __builtin_bit_cast(float, (unsigned)b << 16); }
__device__ __forceinline__ float u2f(unsigned u) { return __builtin_bit_cast(float, u); }
__device__ __forceinline__ float bflo(unsigned w) { return __builtin_bit_cast(float, w << 16); }
__device__ __forceinline__ float bfhi(unsigned w) { return __builtin_bit_cast(float, w & 0xffff0000u); }
__device__ __forceinline__ u32x4 pack8(f32x4 a, f32x4 b) { u32x4 w; w.x = cvt_pk_bf16(a[0], a[1]); w.y = cvt_pk_bf16(a[2], a[3]); w.z = cvt_pk_bf16(b[0], b[1]); w.w = cvt_pk_bf16(b[2], b[3]); return w; }
__device__ __forceinline__ unsigned pack4_fp8(f32x4 v) {
    int w = 0; w = __builtin_amdgcn_cvt_pk_fp8_f32(__builtin_amdgcn_fmed3f(v[0], -448.f, 448.f), __builtin_amdgcn_fmed3f(v[1], -448.f, 448.f), w, false);
    w = __builtin_amdgcn_cvt_pk_fp8_f32(__builtin_amdgcn_fmed3f(v[2], -448.f, 448.f), __builtin_amdgcn_fmed3f(v[3], -448.f, 448.f), w, true); return (unsigned)w;
}
__device__ __forceinline__ float sum_fq(float v) { auto a = __builtin_amdgcn_permlane16_swap(__float_as_uint(v), __float_as_uint(v), false, false); const float s = __uint_as_float(a[0]) + __uint_as_float(a[1]);
    auto b = __builtin_amdgcn_permlane32_swap(__float_as_uint(s), __float_as_uint(s), false, false); return __uint_as_float(b[0]) + __uint_as_float(b[1]); }
__device__ __forceinline__ float fast_exp2(float x) { return __builtin_amdgcn_exp2f(x); }
__device__ __forceinline__ float fast_rcp(float x) { return __builtin_amdgcn_rcpf(x); }
__device__ __forceinline__ float sigmoid_f(float x) { return fast_rcp(1.0f + fast_exp2(-1.4426950408889634f * x)); }
__device__ __forceinline__ float silu_f(float x) { return x * sigmoid_f(x); }
__device__ __forceinline__ float swiglu_raw(float g, float u, float k1, float ic) { return (g * u) * fast_rcp(__builtin_fmaf(fast_exp2(k1 * g), ic, ic)); }
__device__ __forceinline__ float gelu_tanh_f(float x) { const float t = __builtin_fmaf(x * x, -0.10294324f, -2.3022082f); return x * fast_rcp(1.0f + fast_exp2(x * t)); }
template <int CTRL> __device__ __forceinline__ int dpp_i(int v) { return __builtin_amdgcn_mov_dpp(v, CTRL, 0xf, 0xf, true); }
__device__ __forceinline__ float wave_sum(float v) {
    v += __int_as_float(dpp_i<0xB1>(__float_as_int(v))); v += __int_as_float(dpp_i<0x4E>(__float_as_int(v))); v += __int_as_float(dpp_i<0x141>(__float_as_int(v))); v += __int_as_float(dpp_i<0x140>(__float_as_int(v)));
    return sum_fq(v);
}
__device__ __forceinline__ int wave_sum_i(int v) {
    v += dpp_i<0xB1>(v); v += dpp_i<0x4E>(v); v += dpp_i<0x141>(v); v += dpp_i<0x140>(v);
    auto a = __builtin_amdgcn_permlane16_swap((unsigned)v, (unsigned)v, false, false); v = (int)(a[0] + a[1]);
    auto b = __builtin_amdgcn_permlane32_swap((unsigned)v, (unsigned)v, false, false); return (int)(b[0] + b[1]);
}
#define LDS_WAIT() asm volatile("s_waitcnt lgkmcnt(0)" ::: "memory")
#define VM_WAIT() asm volatile("s_waitcnt vmcnt(0)" ::: "memory")

namespace pg8 {
constexpr int BM = 256, BK = 64, HALF = 128, HTB = HALF * BK * 2, STAGE_BYTES = 8 * HTB;
__host__ __device__ __forceinline__ int lds_byte(int r, int c) { const int st = (r >> 4) * 2 + (c >> 5), rr = r & 15, cc = c & 31, ob = rr * 64 + cc * 2; return st * 1024 + (ob ^ (((ob >> 9) & 1) << 5)); }
__host__ __device__ __forceinline__ void stage_rc(int b, int& R, int& C) { const int st = b / 1024, sb = b % 1024, swz = sb ^ (((sb >> 9) & 1) << 5); R = (st >> 1) * 16 + swz / 64; C = (st & 1) * 32 + (swz % 64) / 2; }
__host__ __device__ __forceinline__ int perm32(int rho) { const int n = rho >> 4, i = rho & 15; return 8 * (i >> 2) + 4 * n + (i & 3); }

struct Unit { int nt; int pm, pn, z, ord; int offA, offB; };
struct Gemm { const bf16* A; const bf16* Bt; int lda, ldb, K; size_t zA, zB; };

struct Order2D {
    int nM, nN, nwg, G, c;
    __device__ void init(int nM_, int nN_, int G_, int c_) { nM = nM_; nN = nN_; nwg = nM * nN; G = G_; c = c_; }
    __device__ bool next(int i, Unit& u) const {
        const long L = (long)i * G + c; if (L >= nwg) return false;
        int wgid = (int)L; { const int q = nwg / 8, r = nwg % 8, xcd = wgid % 8, off = wgid / 8; wgid = (xcd < r ? xcd * (q + 1) : r * (q + 1) + (xcd - r) * q) + off; }
        const int nig = 8 * nN, gid = wgid / nig, fm = gid * 8, gsz = (nM - fm) < 8 ? (nM - fm) : 8;
        u.pm = fm + ((wgid % nig) % gsz); u.pn = (wgid % nig) / gsz; u.z = 0; u.ord = i; u.offA = 0; u.offB = 0; u.nt = 0; return true;
    }
    __device__ __forceinline__ void unit_sync() const {}
};
struct OrderBatch {
    int nM, nN, nZ, G, c;
    __device__ void init(int nM_, int nN_, int nZ_, int G_, int c_) { nM = nM_; nN = nN_; nZ = nZ_; G = G_; c = c_; }
    __device__ bool next(int i, Unit& u) const {
        const long L = (long)i * G + c; const int per = nM * nN; if (L >= (long)per * nZ) return false;
        const int z = (int)(L / per), r = (int)(L % per); u.z = z; u.pm = r / nN; u.pn = r % nN; u.ord = i; u.offA = 0; u.offB = 0; u.nt = 0; return true;
    }
    __device__ __forceinline__ void unit_sync() const {}
};
struct OrderMoe {
    const int* pexp; int p0, np, nN, G, c, flat;
    __device__ void init(const int* pexp_, int p0_, int p1_, int nN_, int G_, int c_, int flat_ = 0) { pexp = pexp_; p0 = p0_; np = p1_ > p0_ ? p1_ - p0_ : 0; nN = nN_; G = G_; c = c_; flat = flat_; gb_bar = nullptr; gb_x = 0; gb_st = nullptr; }
    __device__ bool next(int i, Unit& u) const {
        const long L = (long)i * G + c; if (L >= (long)np * nN) return false;
        const int l = (int)L, nig = 8 * nN, gid = l / nig, fm = gid * 8, gsz = (np - fm) < 8 ? (np - fm) : 8;
        u.pm = p0 + fm + ((l % nig) % gsz); u.pn = (l % nig) / gsz; if (flat == 1) { u.pm = p0 + (c & 7); u.pn = (c >> 3) & 3; } else if (flat == 2) { u.pm = p0; u.pn = 0; } else if (flat == 3) { u.pm = p0 + (c & 1); u.pn = (c >> 1) & 1; } else if (flat == 4) { u.pm = p0 + ((u.pm - p0) & 63); } u.z = pexp[u.pm]; u.ord = i; u.offA = 0; u.offB = 0; u.nt = 0; return true;
    }
    unsigned* gb_bar; unsigned gb_x; volatile LAS unsigned* gb_st;
    __device__ __forceinline__ void unit_sync() const;
};

struct OrderPanel {
    int z, pm, nN, nt0;
    __device__ bool next(int i, Unit& u) const { if (i >= nN) return false; u.pm = pm; u.pn = i; u.z = z; u.ord = i; u.offA = 0; u.offB = 0; u.nt = i == 0 ? nt0 : 0; return true; }
    __device__ __forceinline__ void unit_sync() const {}
};
constexpr int KSPLIT = 7;
struct OrderMoeSplit {
    const int* pexp; int p0, np, G, c;
    __device__ void init(const int* pexp_, int p0_, int p1_, int G_, int c_) { pexp = pexp_; p0 = p0_; np = p1_ > p0_ ? p1_ - p0_ : 0; G = G_; c = c_; }
    __device__ bool next(int i, Unit& u) const {
        const long L = (long)i * G + c; if (L >= (long)np * 4 * KSPLIT) return false;
        const int l = (int)L, kq = l % KSPLIT, r = l / KSPLIT; u.pn = r & 3; u.pm = p0 + (r >> 2); u.z = pexp[u.pm]; u.ord = kq; u.offA = kq * 512; u.offB = kq * 512; u.nt = 0; return true;
    }
    __device__ __forceinline__ void unit_sync() const {}
};
typedef int v8i __attribute__((ext_vector_type(8)));
typedef int v4i __attribute__((ext_vector_type(4)));
constexpr int RSL_OFF = 131072, RSL_MAX_UNITS = 15;
template <int NP, class Sched> __device__ __forceinline__ void build_rs_table(LAS unsigned char* lds, const float* st, const Sched& S, float invC) {
    LAS float* RSL = (LAS float*)(lds + RSL_OFF); const int t = threadIdx.x, r = t & 255, i0 = t >> 8;
#pragma unroll
    for (int b = 0; b < 2; ++b) {
        f32x4 v[4][NP / 4]; bool ok[4];
#pragma unroll
        for (int k = 0; k < 4; ++k) { const int i = i0 + 2 * (4 * b + k); Unit u; u.pm = 0; ok[k] = (i < RSL_MAX_UNITS) && S.next(i, u); const size_t row = ok[k] ? (size_t)u.pm * 256 + r : (size_t)r;
#pragma unroll
            for (int q = 0; q < NP / 4; ++q) v[k][q] = *(const f32x4*)(st + row * NP + 4 * q); }
#pragma unroll
        for (int k = 0; k < 4; ++k) { const int i = i0 + 2 * (4 * b + k); float s = 0.f;
#pragma unroll
            for (int q = 0; q < NP / 4; ++q) s += (v[k][q][0] + v[k][q][1]) + (v[k][q][2] + v[k][q][3]);
            if (ok[k]) RSL[i * 256 + r] = rsqrtf(s * invC + EPS); }
    }
    __syncthreads();
}
template <class Epi, class Sched, bool FP8 = false, int NPRE = 0, bool HALFN = false>
__device__ __forceinline__ void gemm_phase(LAS unsigned char* lds, const Gemm g, const Sched& S, const Epi& E, const float* pre_st = nullptr, float pre_inv = 0.f) {
    int tid_ = threadIdx.x; asm volatile("" : "+v"(tid_));
    const int tid = tid_, wid = __builtin_amdgcn_readfirstlane(tid >> 6), lane = tid & 63, wr = wid >> 2, wc = wid & 3, fr = lane & 15, fq = lane >> 4;
    int K_ = g.K; asm volatile("" : "+s"(K_));
    const int K = K_, nt = K / BK;
    unsigned voffA[2], voffB[2];
#pragma unroll
    for (int i = 0; i < 2; ++i) { int R, C; stage_rc(tid * 16 + i * 8192, R, C); const int Rb = (R & ~31) + perm32(R & 31);
        voffA[i] = (unsigned)(R * g.lda + C) * 2u; voffB[i] = (unsigned)(Rb * g.ldb + C) * 2u; }
    const size_t kstep = (size_t)(BK * 2);
    const size_t hstepA = (size_t)HALF * g.lda * 2, hstepB = (size_t)HALF * g.ldb * 2;
    const unsigned ldsw = (unsigned)wid * 1024u;
    const int aoff = FP8 ? lds_byte(wr * 64 + fr, fq * 16) : lds_byte(wr * 64 + fr, fq * 8), boff = FP8 ? lds_byte(wc * 32 + fr, fq * 16) : lds_byte(wc * 32 + fr, fq * 8);
    const int aoff2 = lds_byte(wr * 64 + fr, fq * 16 + 8), boff2 = lds_byte(wc * 32 + fr, fq * 16 + 8);
#define PG8_SA(b, h) (((b) * 2 + (h)) * HTB)
#define PG8_SB(b, h) ((4 + (b) * 2 + (h)) * HTB)
#define PG8_STAGE(bufoff, gbase, voff) do { _Pragma("unroll") for (int _i = 0; _i < 2; ++_i) \
        __builtin_amdgcn_global_load_lds((const unsigned*)((const char*)(gbase) + (voff)[_i]), (LAS unsigned*)(lds + (bufoff) + ldsw + _i * 8192), 16, 0, 0); } while (0)
#define PG8_LD8(p1, p2) __builtin_shufflevector(*(const LAS v4i*)(p1), *(const LAS v4i*)(p2), 0, 1, 2, 3, 4, 5, 6, 7)
#define PG8_LDA8(dst, b, h) do { _Pragma("unroll") for (int m = 0; m < 4; ++m) dst##8[m] = PG8_LD8(lds + PG8_SA(b, h) + aoff + m * 2048, lds + PG8_SA(b, h) + aoff2 + m * 2048); } while (0)
#define PG8_LDB8(dst, b, h) do { _Pragma("unroll") for (int n = 0; n < 2; ++n) dst##8[n] = PG8_LD8(lds + PG8_SB(b, h) + boff + n * 2048, lds + PG8_SB(b, h) + boff2 + n * 2048); } while (0)
#define PG8_LDA(dst, b, h) do { if constexpr (FP8) { PG8_LDA8(dst, b, h); } else { _Pragma("unroll") for (int m = 0; m < 4; ++m) _Pragma("unroll") for (int k = 0; k < 2; ++k) dst[m][k] = *(const LAS bf16x8*)(lds + PG8_SA(b, h) + aoff + m * 2048 + k * 1024); } } while (0)
#define PG8_LDB(dst, b, h) do { if constexpr (FP8) { PG8_LDB8(dst, b, h); } else { _Pragma("unroll") for (int n = 0; n < 2; ++n) _Pragma("unroll") for (int k = 0; k < 2; ++k) dst[n][k] = *(const LAS bf16x8*)(lds + PG8_SB(b, h) + boff + n * 2048 + k * 1024); } } while (0)
#define PG8_V8(x) __builtin_bit_cast(v8i, (x))
#define PG8_MMA(ai, bj, At, Bt) do { __builtin_amdgcn_s_setprio(1); if constexpr (FP8) { _Pragma("unroll") for (int m = 0; m < 4; ++m) _Pragma("unroll") for (int n = 0; n < 2; ++n) \
        asm volatile("v_mfma_scale_f32_16x16x128_f8f6f4 %0, %1, %2, %0, %3, %3 op_sel_hi:[0,0,0]" : "+v"(acc[ai][bj][m][n]) : "v"(Bt##8[n]), "v"(At##8[m]), "v"(fscale)); } else { \
        _Pragma("unroll") for (int m = 0; m < 4; ++m) _Pragma("unroll") for (int n = 0; n < 2; ++n) _Pragma("unroll") for (int k = 0; k < 2; ++k) \
        acc[ai][bj][m][n] = __builtin_amdgcn_mfma_f32_16x16x32_bf16(Bt[n][k], At[m][k], acc[ai][bj][m][n], 0, 0, 0); } __builtin_amdgcn_s_setprio(0); } while (0)
#define PG8_WAIT_V(n) asm volatile("s_waitcnt vmcnt(" #n ")" ::: "memory")
#define PG8_WAIT_L(n) asm volatile("s_waitcnt lgkmcnt(" #n ")" ::: "memory")
#define PG8_BAR __builtin_amdgcn_s_barrier()
#define PG8_SCHED __builtin_amdgcn_sched_barrier(0)
    Unit cur, nxt; int ui = 0;
    if (!S.next(0, cur)) return;
    f32x4 acc[2][2][4][2];
#pragma unroll
    for (int a = 0; a < 2; ++a)
#pragma unroll
        for (int b = 0; b < 2; ++b)
#pragma unroll
            for (int m = 0; m < 4; ++m)
#pragma unroll
                for (int n = 0; n < 2; ++n) acc[a][b][m][n] = (f32x4){0.f, 0.f, 0.f, 0.f};
    bf16x8 At[FP8 ? 1 : 4][2], B0[FP8 ? 1 : 2][2], B1[FP8 ? 1 : 2][2];
    v8i At8[FP8 ? 4 : 1], B08[FP8 ? 2 : 1], B18[FP8 ? 2 : 1];
    int fscale = 0; if constexpr (FP8) { fscale = 0x7f7f7f7f; asm volatile("" : "+v"(fscale)); }
    const char* cA = (const char*)g.A + (size_t)cur.z * g.zA + (size_t)cur.pm * 2 * hstepA + cur.offA; const char* cB = (const char*)g.Bt + (size_t)cur.z * g.zB + (size_t)cur.pn * 2 * hstepB + cur.offB;
    PG8_STAGE(PG8_SB(0, 0), cB, voffB); PG8_STAGE(PG8_SB(0, 1), cB + hstepB, voffB); PG8_STAGE(PG8_SA(0, 0), cA, voffA); PG8_STAGE(PG8_SA(0, 1), cA + hstepA, voffA);
    if constexpr (NPRE > 0) build_rs_table<NPRE>(lds, pre_st, S, pre_inv);
    if (wr == 1) PG8_BAR;
    PG8_WAIT_V(2); PG8_BAR;
    PG8_STAGE(PG8_SB(1, 0), cB + kstep, voffB); PG8_STAGE(PG8_SA(1, 0), cA + kstep, voffA); PG8_STAGE(PG8_SB(1, 1), cB + hstepB + kstep, voffB);
    PG8_WAIT_V(6); PG8_BAR;
    for (;;) {
        const bool has_next = S.next(ui + 1, nxt);
        const char* nA = has_next ? (const char*)g.A + (size_t)nxt.z * g.zA + (size_t)nxt.pm * 2 * hstepA + nxt.offA : cA; const char* nB = has_next ? (const char*)g.Bt + (size_t)nxt.z * g.zB + (size_t)nxt.pn * 2 * hstepB + nxt.offB : cB;
        const int ntu = cur.nt > 0 ? cur.nt : nt;
#pragma unroll 1
        for (int t = 0; t < ntu; t += 2) {
            const bool last = (t == ntu - 2);
            const char* a1 = cA + (size_t)(t + 1) * kstep;
            const char* a2 = last ? nA : cA + (size_t)(t + 2) * kstep; const char* b2 = last ? nB : cB + (size_t)(t + 2) * kstep;
            const char* a3 = a2 + kstep; const char* b3 = b2 + kstep;
            PG8_LDB(B0, 0, 0); if constexpr (!HALFN) PG8_LDB(B1, 0, 1); PG8_SCHED; PG8_LDA(At, 0, 0); PG8_STAGE(PG8_SA(1, 1), a1 + hstepA, voffA);
            PG8_WAIT_V(8); PG8_WAIT_L(0); PG8_BAR; PG8_MMA(0, 0, At, B0); if constexpr (!HALFN) PG8_MMA(0, 1, At, B1); PG8_BAR; PG8_SCHED;
            PG8_LDA(At, 0, 1); PG8_STAGE(PG8_SB(0, 0), b2, voffB); PG8_STAGE(PG8_SB(0, 1), b2 + hstepB, voffB); PG8_STAGE(PG8_SA(0, 0), a2, voffA);
            PG8_WAIT_V(8); PG8_WAIT_L(0); PG8_BAR; PG8_MMA(1, 0, At, B0); if constexpr (!HALFN) PG8_MMA(1, 1, At, B1); PG8_BAR; PG8_SCHED;
            PG8_LDB(B0, 1, 0); if constexpr (!HALFN) PG8_LDB(B1, 1, 1); PG8_SCHED; PG8_LDA(At, 1, 0); PG8_STAGE(PG8_SA(0, 1), a2 + hstepA, voffA);
            PG8_WAIT_V(8); PG8_WAIT_L(0); PG8_BAR; PG8_MMA(0, 0, At, B0); if constexpr (!HALFN) PG8_MMA(0, 1, At, B1); PG8_BAR; PG8_SCHED;
            PG8_LDA(At, 1, 1); PG8_STAGE(PG8_SB(1, 0), b3, voffB); PG8_STAGE(PG8_SB(1, 1), b3 + hstepB, voffB); PG8_STAGE(PG8_SA(1, 0), a3, voffA);
            PG8_WAIT_V(8); PG8_WAIT_L(0); PG8_BAR; PG8_MMA(1, 0, At, B0); if constexpr (!HALFN) PG8_MMA(1, 1, At, B1); PG8_BAR; PG8_SCHED;
        }
        if (wr == 0) PG8_BAR;
        if constexpr (FP8) asm volatile("s_nop 15\n\ts_nop 15" ::: "memory");
        { int el = threadIdx.x; asm volatile("" : "+v"(el));
          E(acc, cur, wr, wc, el & 15, (el >> 4) & 3); }
        S.unit_sync();
        if (!has_next) break;
#pragma unroll
        for (int a = 0; a < 2; ++a)
#pragma unroll
            for (int b = 0; b < 2; ++b)
#pragma unroll
                for (int m = 0; m < 4; ++m)
#pragma unroll
                    for (int n = 0; n < 2; ++n) acc[a][b][m][n] = (f32x4){0.f, 0.f, 0.f, 0.f};
        cur = nxt; cA = nA; cB = nB; ++ui;
        if (wr == 1) PG8_BAR;
    }
    PG8_WAIT_V(0);
    PG8_BAR;
#undef PG8_SA
#undef PG8_SB
#undef PG8_STAGE
#undef PG8_LDA
#undef PG8_LDB
#undef PG8_MMA
#undef PG8_V8
#undef PG8_LDA8
#undef PG8_LDB8
#undef PG8_LD8
#undef PG8_WAIT_V
#undef PG8_WAIT_L
#undef PG8_BAR
#undef PG8_SCHED
}

typedef const f32x4 (&Acc)[2][2][4][2];
#define EPI_ARGS Acc acc, const Unit& u, int wr, int wc, int fr, int fq
#define FOR_ROWS _Pragma("unroll") for (int ai = 0; ai < 2; ++ai) _Pragma("unroll") for (int m = 0; m < 4; ++m)
#define ROW_OF (u.pm * 256 + ai * 128 + wr * 64 + m * 16 + fr)

__device__ __forceinline__ const LAS float* rs_base(LAS unsigned char* lds, const Unit& u, int wr, int fr) { int o = (u.ord * 256 + wr * 64 + fr) * 4 + RSL_OFF; asm volatile("" : "+v"(o)); return (const LAS float*)(lds + o); }
#define RS_OF(lds) (rsb[ai * 128 + m * 16])
__device__ __forceinline__ float sumsq8(f32x4 a, f32x4 b) { return (a[0] * a[0] + a[1] * a[1]) + (a[2] * a[2] + a[3] * a[3]) + (b[0] * b[0] + b[1] * b[1]) + (b[2] * b[2] + b[3] * b[3]); }

struct EpiUin { LAS unsigned char* lds; bf16* UG;
    __device__ __forceinline__ void operator()(EPI_ARGS) const {
        const LAS float* rsb = rs_base(lds, u, wr, fr);
        FOR_ROWS { const int row = ROW_OF; const float rs = RS_OF(lds);
            const int b = row >> 12, t = row & 4095, c = t >> 5, j = t & 31;
#pragma unroll
            for (int bj = 0; bj < 2; ++bj) { const int col0 = u.pn * 256 + bj * 128 + wc * 32 + 8 * fq, gg = col0 >> 4, m0 = col0 & 15;
                *(u32x4*)(UG + ((size_t)(gg * BC + b * NCH + c)) * UGLD + UC0 + j * 16 + m0) = pack8(acc[ai][bj][m][0] * rs, acc[ai][bj][m][1] * rs); } }
    }
};
struct EpiEnd { float* E;
    __device__ __forceinline__ void operator()(EPI_ARGS) const {
        FOR_ROWS { const int row = ROW_OF; float* p = E + ((size_t)u.z * BC + row) * 128 + wc * 32 + 8 * fq;
            *(f32x4*)p = acc[ai][0][m][0]; *(f32x4*)(p + 4) = acc[ai][0][m][1]; }
    }
};
struct EpiS5Y { bf16* YB;
    __device__ __forceinline__ void operator()(EPI_ARGS) const {
        FOR_ROWS { const int row = ROW_OF; const int b = row >> 7, c = row & 127;
#pragma unroll
            for (int bj = 0; bj < 2; ++bj) { const int col0 = u.pn * 256 + bj * 128 + wc * 32 + 8 * fq, i = col0 >> 4, n0 = col0 & 15;
                f32x4 v0 = acc[ai][bj][m][0], v1 = acc[ai][bj][m][1];
#pragma unroll
                for (int e = 0; e < 4; ++e) { v0[e] = gelu_tanh_f(v0[e]); v1[e] = gelu_tanh_f(v1[e]); }
                *(u32x4*)(YB + ((size_t)(b * SEQ + c * TCH + i)) * DM + u.z * 16 + n0) = pack8(v0, v1); } }
    }
};
struct EpiGlu { const bf16* YB; bf16* ZB;
    __device__ __forceinline__ void operator()(EPI_ARGS) const {
        u32x4 y[2][4][2];
        FOR_ROWS { const int row = ROW_OF;
#pragma unroll
            for (int bj = 0; bj < 2; ++bj) y[ai][m][bj] = *(const u32x4*)(YB + (size_t)row * DM + u.pn * 256 + bj * 128 + wc * 32 + 8 * fq); }
        FOR_ROWS { const int row = ROW_OF;
#pragma unroll
            for (int bj = 0; bj < 2; ++bj) { const int col0 = u.pn * 256 + bj * 128 + wc * 32 + 8 * fq; const size_t o = (size_t)row * DM + col0;
                const u32x4 yy = y[ai][m][bj]; f32x4 v0 = acc[ai][bj][m][0], v1 = acc[ai][bj][m][1];
                v0[0] = bflo(yy.x) * sigmoid_f(v0[0]); v0[1] = bfhi(yy.x) * sigmoid_f(v0[1]); v0[2] = bflo(yy.y) * sigmoid_f(v0[2]); v0[3] = bfhi(yy.y) * sigmoid_f(v0[3]);
                v1[0] = bflo(yy.z) * sigmoid_f(v1[0]); v1[1] = bfhi(yy.z) * sigmoid_f(v1[1]); v1[2] = bflo(yy.w) * sigmoid_f(v1[2]); v1[3] = bfhi(yy.w) * sigmoid_f(v1[3]);
                *(u32x4*)(ZB + o) = pack8(v0, v1); } }
    }
};
template <int MODE> struct EpiResid { const float* xin; float* XF; bf16* XB; float* st; float bs;
    __device__ __forceinline__ void operator()(EPI_ARGS) const {
        if constexpr (MODE != 0) {
            u32x4 w[2][4][2];
            FOR_ROWS { const int row = ROW_OF;
#pragma unroll
                for (int bj = 0; bj < 2; ++bj) w[ai][m][bj] = *(const u32x4*)(XB + (size_t)row * DM + u.pn * 256 + bj * 128 + wc * 32 + 8 * fq); }
            FOR_ROWS { const int row = ROW_OF; float ss = 0.f;
#pragma unroll
                for (int bj = 0; bj < 2; ++bj) { const size_t o = (size_t)row * DM + u.pn * 256 + bj * 128 + wc * 32 + 8 * fq; const u32x4 ww = w[ai][m][bj];
                    const f32x4 v0 = (f32x4){bflo(ww.x), bfhi(ww.x), bflo(ww.y), bfhi(ww.y)} + acc[ai][bj][m][0] * bs, v1 = (f32x4){bflo(ww.z), bfhi(ww.z), bflo(ww.w), bfhi(ww.w)} + acc[ai][bj][m][1] * bs;
                    if (MODE == 2) { *(f32x4*)(XF + o) = v0; *(f32x4*)(XF + o + 4) = v1; }
                    else { *(u32x4*)(XB + o) = pack8(v0, v1); if (MODE != 3) ss += sumsq8(v0, v1); } }
                if (MODE != 2 && MODE != 3) { ss = sum_fq(ss); if (fq == 0) st[(size_t)row * 16 + u.pn * 4 + wc] = ss; } }
            return;
        }
#pragma unroll
        for (int ai = 0; ai < 2; ++ai) {
            f32x4 x[4][2][2];
#pragma unroll
            for (int m = 0; m < 4; ++m) { const int row = ROW_OF;
#pragma unroll
                for (int bj = 0; bj < 2; ++bj) { const size_t o = (size_t)row * DM + u.pn * 256 + bj * 128 + wc * 32 + 8 * fq;
                    if (MODE == 0) { x[m][bj][0] = *(const f32x4*)(xin + o); x[m][bj][1] = *(const f32x4*)(xin + o + 4); }
                    else { const u32x4 w = *(const u32x4*)(XB + o); x[m][bj][0] = (f32x4){bflo(w.x), bfhi(w.x), bflo(w.y), bfhi(w.y)}; x[m][bj][1] = (f32x4){bflo(w.z), bfhi(w.z), bflo(w.w), bfhi(w.w)}; } } }
#pragma unroll
            for (int m = 0; m < 4; ++m) { const int row = ROW_OF; float ss = 0.f;
#pragma unroll
                for (int bj = 0; bj < 2; ++bj) { const size_t o = (size_t)row * DM + u.pn * 256 + bj * 128 + wc * 32 + 8 * fq;
                    const f32x4 v0 = x[m][bj][0] + acc[ai][bj][m][0] * bs, v1 = x[m][bj][1] + acc[ai][bj][m][1] * bs;
                    if (MODE == 2) { *(f32x4*)(XF + o) = v0; *(f32x4*)(XF + o + 4) = v1; }
                    else { *(u32x4*)(XB + o) = pack8(v0, v1); if (MODE != 3) ss += sumsq8(v0, v1); } }
                if (MODE != 2 && MODE != 3) { ss = sum_fq(ss); if (fq == 0) st[(size_t)row * 16 + u.pn * 4 + wc] = ss; } }
        }
    }
};
struct EpiSwiglu { LAS unsigned char* lds; bf16* H; int ldh; int row_sub; int use_rs; int mode;
    __device__ __forceinline__ void operator()(EPI_ARGS) const {
        const LAS float* rsb = use_rs ? rs_base(lds, u, wr, fr) : (const LAS float*)lds;
        if (mode == 3) return;
        FOR_ROWS { const int row = ROW_OF; const float rs = use_rs ? RS_OF(lds) : 1.0f;
            f32x4 g0 = acc[ai][0][m][0] * rs, g1 = acc[ai][0][m][1] * rs; const f32x4 u0 = acc[ai][1][m][0] * rs, u1 = acc[ai][1][m][1] * rs;
#pragma unroll
            for (int e = 0; e < 4; ++e) { if (mode == 2) { g0[e] = g0[e] + u0[e]; g1[e] = g1[e] + u1[e]; } else { g0[e] = silu_f(g0[e]) * u0[e]; g1[e] = silu_f(g1[e]) * u1[e]; } }
            *(u32x4*)(H + (size_t)(row - row_sub) * ldh + u.pn * 128 + wc * 32 + 8 * fq) = pack8(g0, g1); }
    }
};
struct RopeTab { f32x4 cA, cB, sA, sB; };
__device__ __forceinline__ RopeTab rope_load(const float* cosb, const float* sinb, int row, int fq) {
    const int c0 = (8 * fq) & 15; RopeTab t; t.cA = *(const f32x4*)(cosb + (size_t)row * 16 + c0); t.cB = *(const f32x4*)(cosb + (size_t)row * 16 + c0 + 4);
    t.sA = *(const f32x4*)(sinb + (size_t)row * 16 + c0); t.sB = *(const f32x4*)(sinb + (size_t)row * 16 + c0 + 4); return t;
}
__device__ __forceinline__ void rope8(f32x4& v0, f32x4& v1, const RopeTab& t, int fq) {
    f32x4 p0, p1;
#pragma unroll
    for (int e = 0; e < 4; ++e) { auto s0 = __builtin_amdgcn_permlane32_swap(__float_as_uint(v0[e]), __float_as_uint(v0[e]), false, false); auto s1 = __builtin_amdgcn_permlane32_swap(__float_as_uint(v1[e]), __float_as_uint(v1[e]), false, false);
        p0[e] = __uint_as_float(fq < 2 ? s0[1] : s0[0]); p1[e] = __uint_as_float(fq < 2 ? s1[1] : s1[0]); }
    if (fq < 2) { v0 = v0 * t.cA - p0 * t.sA; v1 = v1 * t.cB - p1 * t.sB; }
    else        { v0 = v0 * t.cA + p0 * t.sA; v1 = v1 * t.cB + p1 * t.sB; }
}
struct EpiKvq { LAS unsigned char* lds; bf16* CKV; bf16* CQ; bf16* KR; float* stkv; float* stq; const float* cosb; const float* sinb;
    __device__ __forceinline__ void operator()(EPI_ARGS) const {
        const LAS float* rsb = rs_base(lds, u, wr, fr);
        if (u.pn == 3) {
            if (wc == 0) {
#pragma unroll
                for (int ai = 0; ai < 2; ++ai) { RopeTab t[4];
#pragma unroll
                    for (int m = 0; m < 4; ++m) t[m] = rope_load(cosb, sinb, ROW_OF, fq);
#pragma unroll
                    for (int m = 0; m < 4; ++m) { const int row = ROW_OF; const float rs = RS_OF(lds); f32x4 v0 = acc[ai][0][m][0] * rs, v1 = acc[ai][0][m][1] * rs;
                        rope8(v0, v1, t[m], fq); *(u32x4*)(KR + (size_t)row * 32 + 8 * fq) = pack8(v0, v1); } }
            }
            return;
        }
        FOR_ROWS { const int row = ROW_OF; const float rs = RS_OF(lds); float ss = 0.f;
#pragma unroll
            for (int bj = 0; bj < 2; ++bj) { const int cl = bj * 128 + wc * 32 + 8 * fq; const f32x4 v0 = acc[ai][bj][m][0] * rs, v1 = acc[ai][bj][m][1] * rs; ss += sumsq8(v0, v1);
                if (u.pn == 0) *(u32x4*)(CKV + (size_t)row * KVL + cl) = pack8(v0, v1); else *(u32x4*)(CQ + (size_t)row * QL + (u.pn - 1) * 256 + cl) = pack8(v0, v1); }
            ss = sum_fq(ss);
            if (fq == 0) { if (u.pn == 0) stkv[(size_t)row * 4 + wc] = ss; else stq[(size_t)row * 8 + (u.pn - 1) * 4 + wc] = ss; } }
    }
};
struct EpiUkv { LAS unsigned char* lds; bf16* KN; bf16* VB;
    __device__ __forceinline__ void operator()(EPI_ARGS) const {
        bf16* dst = u.pn < 4 ? KN : VB; const int ct = (u.pn & 3) * 256; const LAS float* rsb = rs_base(lds, u, wr, fr);
        FOR_ROWS { const int row = ROW_OF; const float rs = RS_OF(lds);
#pragma unroll
            for (int bj = 0; bj < 2; ++bj) *(u32x4*)(dst + (size_t)row * DM + ct + bj * 128 + wc * 32 + 8 * fq) = pack8(acc[ai][bj][m][0] * rs, acc[ai][bj][m][1] * rs); }
    }
};
struct EpiUq { LAS unsigned char* lds; bf16* QN; bf16* QR; const float* cosb; const float* sinb;
    __device__ __forceinline__ void operator()(EPI_ARGS) const {
        const LAS float* rsb = rs_base(lds, u, wr, fr);
        if (u.pn < 4) {
            FOR_ROWS { const int row = ROW_OF; const float rs = RS_OF(lds) * QSCALE;
#pragma unroll
                for (int bj = 0; bj < 2; ++bj) *(u32x4*)(QN + (size_t)row * DM + u.pn * 256 + bj * 128 + wc * 32 + 8 * fq) = pack8(acc[ai][bj][m][0] * rs, acc[ai][bj][m][1] * rs); }
            return;
        }
#pragma unroll
        for (int ai = 0; ai < 2; ++ai) { RopeTab t[4];
#pragma unroll
            for (int m = 0; m < 4; ++m) t[m] = rope_load(cosb, sinb, ROW_OF, fq);
#pragma unroll
            for (int m = 0; m < 4; ++m) { const int row = ROW_OF; const float rs = RS_OF(lds) * QSCALE;
#pragma unroll
                for (int bj = 0; bj < 2; ++bj) { f32x4 v0 = acc[ai][bj][m][0] * rs, v1 = acc[ai][bj][m][1] * rs; rope8(v0, v1, t[m], fq);
                    *(u32x4*)(QR + (size_t)row * 512 + (u.pn - 4) * 256 + bj * 128 + wc * 32 + 8 * fq) = pack8(v0, v1); } } }
    }
};
struct EpiSwigluF8R { LAS unsigned char* lds; unsigned char* H8; int ldh;
    __device__ __forceinline__ void operator()(EPI_ARGS) const {
        const LAS float* rsb = rs_base(lds, u, wr, fr);
#pragma unroll
        for (int ai = 0; ai < 2; ++ai)
#pragma unroll
            for (int mp = 0; mp < 4; mp += 2) { u32x2 w[2];
#pragma unroll
                for (int q = 0; q < 2; ++q) { const int m = mp + q; const float rs = RS_OF(lds); const float k1 = -1.4426950408889634f * rs, ic = fast_rcp(rs * rs * FS_H);
                    f32x4 g0, g1;
#pragma unroll
                    for (int e = 0; e < 4; ++e) { g0[e] = swiglu_raw(acc[ai][0][m][0][e], acc[ai][1][m][0][e], k1, ic); g1[e] = swiglu_raw(acc[ai][0][m][1][e], acc[ai][1][m][1][e], k1, ic); }
                    w[q] = (u32x2){pack4_fp8(g0), pack4_fp8(g1)}; }
                const auto s0 = __builtin_amdgcn_permlane16_swap(w[0].x, w[1].x, false, false), s1 = __builtin_amdgcn_permlane16_swap(w[0].y, w[1].y, false, false);
                const int m = mp + (fq & 1), row = ROW_OF;
                *(u32x4*)(H8 + (size_t)row * ldh + u.pn * 128 + wc * 32 + 16 * (fq >> 1)) = (u32x4){s0[0], s1[0], s0[1], s1[1]}; }
    }
};
struct EpiSwigluF8 { unsigned char* H8; int ldh; int row_sub; float sc;
    __device__ __forceinline__ void operator()(EPI_ARGS) const {
#pragma unroll
        for (int ai = 0; ai < 2; ++ai)
#pragma unroll
            for (int mp = 0; mp < 4; mp += 2) { u32x2 w[2];
#pragma unroll
                for (int q = 0; q < 2; ++q) { const int m = mp + q;
                    f32x4 g0, g1; const float k1 = -1.4426950408889634f * sc, ic = 1.0f / (sc * sc * FS_H);
#pragma unroll
                    for (int e = 0; e < 4; ++e) { g0[e] = swiglu_raw(acc[ai][0][m][0][e], acc[ai][1][m][0][e], k1, ic); g1[e] = swiglu_raw(acc[ai][0][m][1][e], acc[ai][1][m][1][e], k1, ic); }
                    w[q] = (u32x2){pack4_fp8(g0), pack4_fp8(g1)}; }
                const auto s0 = __builtin_amdgcn_permlane16_swap(w[0].x, w[1].x, false, false), s1 = __builtin_amdgcn_permlane16_swap(w[0].y, w[1].y, false, false);
                const int m = mp + (fq & 1), row = ROW_OF;
                *(u32x4*)(H8 + (size_t)(row - row_sub) * ldh + u.pn * 128 + wc * 32 + 16 * (fq >> 1)) = (u32x4){s0[0], s1[0], s0[1], s1[1]}; }
    }
};
struct EpiSlab { bf16* S; float sc;
    __device__ __forceinline__ void operator()(EPI_ARGS) const {
        FOR_ROWS { const int row = ROW_OF;
#pragma unroll
            for (int bj = 0; bj < 2; ++bj) *(u32x4*)(S + ((size_t)u.ord * 2048 + (row - 65536)) * DM + u.pn * 256 + bj * 128 + wc * 32 + 8 * fq) = pack8(acc[ai][bj][m][0] * sc, acc[ai][bj][m][1] * sc); }
    }
};
struct EpiPlain { bf16* O; int ldo; int rmask; float sc;
    __device__ __forceinline__ void operator()(EPI_ARGS) const {
        FOR_ROWS { const int row = ROW_OF;
#pragma unroll
            for (int bj = 0; bj < 2; ++bj) *(u32x4*)(O + (size_t)(row & rmask) * ldo + u.pn * 256 + bj * 128 + wc * 32 + 8 * fq) = pack8(acc[ai][bj][m][0] * sc, acc[ai][bj][m][1] * sc); }
    }
};
}

namespace attn {
constexpr int KSLOT = 12288, VSLOT = 8192;
constexpr int NKS = 4, NVS = 3;
constexpr int L_K = 0, L_V = NKS * KSLOT, L_WS = L_V + NVS * VSLOT, L_OST = L_WS + 8 * 64 * 4, L_BYTES = L_OST + 8 * 4096;
__device__ __forceinline__ int crow(int r, int hi) { return (r & 3) + 8 * (r >> 2) + 4 * hi; }
__device__ __forceinline__ float max3f(float a, float b, float c) { return __builtin_fmaxf(__builtin_fmaxf(a, b), c); }

__device__ __forceinline__ float xhalf_max(float m) { auto rr = __builtin_amdgcn_permlane32_swap(__float_as_uint(m), __float_as_uint(m), false, false); return __builtin_fmaxf(__uint_as_float(rr[0]), __uint_as_float(rr[1])); }
__device__ __forceinline__ float xhalf_sum(float m) { auto rr = __builtin_amdgcn_permlane32_swap(__float_as_uint(m), __float_as_uint(m), false, false); return __uint_as_float(rr[0]) + __uint_as_float(rr[1]); }
__device__ __forceinline__ float rowmax32(const f32x16& p0, const f32x16& p1) {
    float a = max3f(p0[0], p0[1], p1[0]), b = max3f(p0[2], p0[3], p1[1]); a = max3f(a, p1[2], p1[3]);
#pragma unroll
    for (int r = 4; r < 16; r += 4) { a = max3f(a, p0[r], p0[r + 1]); b = max3f(b, p0[r + 2], p0[r + 3]); a = max3f(a, p1[r], p1[r + 1]); b = max3f(b, p1[r + 2], p1[r + 3]); }
    return xhalf_max(__builtin_fmaxf(a, b));
}
template <int ORD> __device__ __forceinline__ void attn_unit(int b, int h, int qb, const bf16* QN, const bf16* QR, const bf16* KN, const bf16* KR, const bf16* VB, bf16* O, LAS unsigned char* shm) {
    int tid_ = threadIdx.x; asm volatile("" : "+v"(tid_));
    const int tid = tid_, lane = tid & 63, r32 = lane & 31, hi = lane >> 5; const int wid = __builtin_amdgcn_readfirstlane(tid >> 6);
    const long rowbase = (long)b * SEQ; const int q0 = qb * 256;
    const int NT = (q0 + 256) / 64;
    const int tmax = (q0 + 32 * wid) >> 6;
    LAS float* wsf = (LAS float*)(shm + L_WS) + wid * 64;
    const bf16* ksrc0 = KN + (rowbase + lane) * DM + h * 64 + wid * 8;
    const bf16* ksrc1 = KR + (rowbase + lane) * 32 + (wid & 3) * 8;
    const bf16* vsrc = VB + (rowbase + 16 * (wid & 3) + (lane >> 2)) * DM + h * 64 + (wid >> 2) * 32 + (lane & 3) * 8;
#define DMA_K(t, s) do { \
        __builtin_amdgcn_global_load_lds((const unsigned*)(ksrc0 + (long)(t) * 64 * DM), (LAS unsigned*)(shm + L_K + (s) * KSLOT + wid * 1024), 16, 0, 0); \
        if (wid < 4) __builtin_amdgcn_global_load_lds((const unsigned*)(ksrc1 + (long)(t) * 64 * 32), (LAS unsigned*)(shm + L_K + (s) * KSLOT + (8 + wid) * 1024), 16, 0, 0); } while (0)
#define DMA_V(t, s) __builtin_amdgcn_global_load_lds((const unsigned*)(vsrc + (long)(t) * 64 * DM), (LAS unsigned*)(shm + L_V + (s) * VSLOT + wid * 1024), 16, 0, 0)
    DMA_K(0, 0);
    bf16x8 qr[6];
    { const long qrow = rowbase + q0 + wid * 32 + r32;
#pragma unroll
      for (int d0 = 0; d0 < 4; ++d0) qr[d0] = *(const bf16x8*)(QN + qrow * DM + h * 64 + d0 * 16 + hi * 8);
#pragma unroll
      for (int d0 = 0; d0 < 2; ++d0) qr[4 + d0] = *(const bf16x8*)(QR + qrow * 512 + h * 32 + d0 * 16 + hi * 8); }
    asm volatile("" ::: "memory");
    DMA_K(1, 1); DMA_V(0, 0); DMA_K(2, 2);
    float mhat = 0.f, l_reg = 0.f; f32x16 o[2]; o[0] = f32x16{}; o[1] = f32x16{}; f32x16 negm = f32x16{};
    const unsigned vbase = (unsigned)(uintptr_t)(shm + L_V) + ((lane >> 4) & 1) * 32 + (lane & 3) * 8 + (4 * hi + ((lane & 15) >> 2)) * 64;
    const LAS unsigned char* kbase = shm + L_K + hi * 1024 + r32 * 16;
    bf16x8 kf[2], kg[2]; const unsigned kbase_u = (unsigned)(uintptr_t)kbase;
#define KRD(dst, off) asm volatile("ds_read_b128 %0,%1 offset:%c2" : "=&v"(dst) : "v"(kaddr_), "i"(off) : "memory")
#define KLOAD1(dst, s, d) do { const unsigned kaddr_ = kbase_u + (unsigned)(s) * KSLOT; KRD(dst[0], (d) * 2048); KRD(dst[1], (d) * 2048 + 512); } while (0)
#define KTIE2(dst, n) asm volatile("s_waitcnt lgkmcnt(" #n ")" : "+v"(dst[0]), "+v"(dst[1]) :: "memory")
#define QK1(P0, P1, fr, d) do { \
        P0 = __builtin_amdgcn_mfma_f32_32x32x16_bf16(fr[0], qr[d], (d) == 0 ? negm : P0, 0, 0, 0); P1 = __builtin_amdgcn_mfma_f32_32x32x16_bf16(fr[1], qr[d], (d) == 0 ? negm : P1, 0, 0, 0); __builtin_amdgcn_sched_barrier(0); } while (0)
#define QKM(P0, P1, s) do { KLOAD1(kf, s, 0); KLOAD1(kg, s, 1); KTIE2(kf, 2); QK1(P0, P1, kf, 0); KTIE2(kg, 0); KLOAD1(kf, s, 2); QK1(P0, P1, kg, 1); KTIE2(kf, 0); KLOAD1(kg, s, 3); QK1(P0, P1, kf, 2); KTIE2(kg, 0); \
        KLOAD1(kf, s, 4); QK1(P0, P1, kg, 3); KTIE2(kf, 0); KLOAD1(kg, s, 5); QK1(P0, P1, kf, 4); KTIE2(kg, 0); QK1(P0, P1, kg, 5); } while (0)
#define VF(i) (bf16x8){lo[i][0], lo[i][1], lo[i][2], lo[i][3], hh[i][0], hh[i][1], hh[i][2], hh[i][3]}
#define TRRD(dst, off) asm volatile("ds_read_b64_tr_b16 %0,%1 offset:%c2" : "=&v"(dst) : "v"(vb_), "i"(off) : "memory")
#define VWAIT(n, j) asm volatile("s_waitcnt lgkmcnt(" #n ")" : "+v"(lo[j]), "+v"(hh[j]), "+v"(lo[(j) + 4]), "+v"(hh[(j) + 4]) :: "memory")
#define PVISSUE(tt) do { const unsigned vb_ = vbase + ((tt) % 3) * VSLOT; \
        _Pragma("unroll") for (int j = 0; j < 4; ++j) { TRRD(lo[j], j * 1024); TRRD(hh[j], j * 1024 + 512); TRRD(lo[j + 4], 4096 + j * 1024); TRRD(hh[j + 4], 4096 + j * 1024 + 512); } } while (0)
#define PVPAIR(PW, j) do { o[0] = __builtin_amdgcn_mfma_f32_32x32x16_bf16(__builtin_bit_cast(bf16x8, PW[j]), VF(j), o[0], 0, 0, 0); o[1] = __builtin_amdgcn_mfma_f32_32x32x16_bf16(__builtin_bit_cast(bf16x8, PW[j]), VF((j) + 4), o[1], 0, 0, 0); __builtin_amdgcn_sched_barrier(0); } while (0)
#define PVMM_0(PW) do { VWAIT(12, 0); PVPAIR(PW, 0); VWAIT(8, 1); PVPAIR(PW, 1); VWAIT(4, 2); PVPAIR(PW, 2); VWAIT(0, 3); PVPAIR(PW, 3); } while (0)
#define OSCALE() do { LDS_WAIT(); _Pragma("unroll") for (int d = 0; d < 2; ++d) _Pragma("unroll") for (int r = 0; r < 16; ++r) o[d][r] *= wsf[crow(r, hi)]; } while (0)
#define MBLOCK(N0, N1, PWP, t, ORD) do { s16x4 lo[8], hh[8]; \
        const bool dopv_ = (t) >= 1 && (t) - 1 <= tmax; \
        if (dopv_) { PVISSUE((t) - 1); VWAIT(12, 0); PVPAIR(PWP, 0); VWAIT(8, 1); PVPAIR(PWP, 1); VWAIT(4, 2); PVPAIR(PWP, 2); VWAIT(0, 3); PVPAIR(PWP, 3); } \
        if ((ORD) == 1 && resc) OSCALE(); \
        if (nx) QKM(N0, N1, ((t) + 1) & 3); } while (0)
#define VBLOCK(C0, C1, N0, N1, PWN, t, ORD) do { \
        const float rm = rowmax32(C0, C1); \
        if ((t) == 0 || __any(rm > 8.0f)) { \
            const float dl = (t) == 0 ? rm : __builtin_fmaxf(rm, 0.f); mhat += dl; \
            _Pragma("unroll") for (int r = 0; r < 16; ++r) { C0[r] -= dl; C1[r] -= dl; negm[r] = -mhat; } \
            if ((ORD) == 0 && nx) { _Pragma("unroll") for (int r = 0; r < 16; ++r) { N0[r] -= dl; N1[r] -= dl; } }     \
            const float f = fast_exp2(-dl); l_reg *= f; \
            if ((t) != 0) { if (hi == 0) wsf[r32] = f; if ((ORD) == 0) OSCALE(); else resc = true; } } \
        float sacc = 0.f;     \
        _Pragma("unroll") for (int r = 0; r < 16; ++r) { C0[r] = fast_exp2(C0[r]); C1[r] = fast_exp2(C1[r]); sacc += C0[r]; sacc += C1[r]; } \
        l_reg += sacc; \
        PWN[0] = (u32x4){cvt_pk_bf16(C0[0], C0[1]), cvt_pk_bf16(C0[2], C0[3]), cvt_pk_bf16(C0[4], C0[5]), cvt_pk_bf16(C0[6], C0[7])}; \
        PWN[1] = (u32x4){cvt_pk_bf16(C0[8], C0[9]), cvt_pk_bf16(C0[10], C0[11]), cvt_pk_bf16(C0[12], C0[13]), cvt_pk_bf16(C0[14], C0[15])}; \
        PWN[2] = (u32x4){cvt_pk_bf16(C1[0], C1[1]), cvt_pk_bf16(C1[2], C1[3]), cvt_pk_bf16(C1[4], C1[5]), cvt_pk_bf16(C1[6], C1[7])}; \
        PWN[3] = (u32x4){cvt_pk_bf16(C1[8], C1[9]), cvt_pk_bf16(C1[10], C1[11]), cvt_pk_bf16(C1[12], C1[13]), cvt_pk_bf16(C1[14], C1[15])}; } while (0)
#define STEP(C0, C1, N0, N1, PWP, PWN, t, ORD) do { \
        if ((t) + 2 < NT) asm volatile("s_waitcnt vmcnt(2) lgkmcnt(0)\n\ts_barrier" ::: "memory");     \
        else asm volatile("s_waitcnt vmcnt(1) lgkmcnt(0)\n\ts_barrier" ::: "memory"); \
        if ((t) + 3 < NT) DMA_K((t) + 3, ((t) + 3) & 3); \
        if ((t) + 1 < NT) DMA_V((t) + 1, ((t) + 1) % 3); \
        const bool nx = ((t) + 1 <= tmax) && ((t) + 1 < NT); bool resc = false; \
        if ((ORD) == 0) { MBLOCK(N0, N1, PWP, t, 0); if ((t) <= tmax) VBLOCK(C0, C1, N0, N1, PWN, t, 0); } \
        else { if ((t) <= tmax) VBLOCK(C0, C1, N0, N1, PWN, t, 1); MBLOCK(N0, N1, PWP, t, 1); } } while (0)
    f32x16 pA0, pA1, pB0, pB1; u32x4 pwX[4], pwY[4];
    asm volatile("s_waitcnt vmcnt(3) lgkmcnt(0)\n\ts_barrier" ::: "memory");
    QKM(pA0, pA1, 0);
    for (int t = 0; t < NT; t += 2) { STEP(pA0, pA1, pB0, pB1, pwY, pwX, t, ORD); STEP(pB0, pB1, pA0, pA1, pwX, pwY, t + 1, ORD); }
    asm volatile("s_waitcnt vmcnt(0) lgkmcnt(0)\n\ts_barrier" ::: "memory");
    if (tmax >= NT - 1) { s16x4 lo[8], hh[8]; PVISSUE(NT - 1); PVMM_0(pwY); }
#undef STEP
#undef VBLOCK
#undef MBLOCK
#undef OSCALE
#undef PVISSUE
#undef PVPAIR
#undef PVMM_0
#undef TRRD
#undef VWAIT
#undef VF
#undef KRD
#undef KLOAD1
#undef KTIE2
#undef QK1
#undef QKM
    l_reg = xhalf_sum(l_reg);
    if (hi == 0) wsf[32 + r32] = l_reg; LDS_WAIT();
    bf16* Ow = O + (rowbase + q0 + wid * 32) * DM + h * 64;
    { LAS bf16* stg = (LAS bf16*)(shm + L_OST) + wid * 2048;
#pragma unroll
      for (int r = 0; r < 16; ++r) { const int orow = crow(r, hi); const float rl = fast_rcp(wsf[32 + orow]);
#pragma unroll
          for (int d0 = 0; d0 < 2; ++d0) stg[orow * 64 + d0 * 32 + r32] = (bf16)(cvt_pk_bf16(o[d0][r] * rl, 0.f) & 0xffffu); }
      LDS_WAIT();
#pragma unroll
      for (int i = 0; i < 4; ++i) { const int row = i * 8 + (lane >> 3), ch = lane & 7; const u32x4 v = *(const LAS u32x4*)(stg + row * 64 + ch * 8); *(u32x4*)(Ow + (long)row * DM + ch * 8) = v; } }
    asm volatile("s_waitcnt lgkmcnt(0)\n\ts_barrier" ::: "memory");
#undef DMA_K
#undef DMA_V
}
}

#define XB_TMO      128
#define XB_XCNT(j)  (256  + 64 * (j))
#define XB_XSUB(j)  (1280 + 64 * (j))
#define XB_XGEN(j)  (2304 + 64 * (j))
#define XB_TOP      3328
#define XB_TOPGEN   3392
#define XCD_BAR_WORDS 3456
#define XB_SPIN_CAP (1u << 22)
__device__ __forceinline__ unsigned xb_ld(unsigned* p)              { return __hip_atomic_load(p, __ATOMIC_RELAXED, __HIP_MEMORY_SCOPE_AGENT); }
__device__ __forceinline__ unsigned xb_add(unsigned* p, unsigned v) { return __hip_atomic_fetch_add(p, v, __ATOMIC_RELAXED, __HIP_MEMORY_SCOPE_AGENT); }
__device__ __forceinline__ unsigned xb_xcc_id() { return (unsigned)__builtin_amdgcn_s_getreg((3 << 11) | 20) & 0xFu; }
#define XB_SPIN(cond, bar) do { unsigned _sp = 0; while (cond) { __builtin_amdgcn_s_sleep(1); \
    if ((++_sp & 255u) == 0u) { if (xb_ld(&(bar)[XB_TMO])) break; if (_sp > XB_SPIN_CAP) { atomicAdd(&(bar)[XB_TMO], 1u); break; } } } } while (0)
struct XcdBarrier { unsigned* bar; unsigned x; volatile LAS unsigned* st; };
__device__ __forceinline__ XcdBarrier xcd_barrier_post(unsigned* bar, volatile LAS unsigned* st) {
    XcdBarrier b; b.bar = bar; b.x = xb_xcc_id(); b.st = st;
    if (threadIdx.x == 0) (void)xb_add(&bar[XB_XCNT(b.x)], 1u);
    return b;
}
__device__ __forceinline__ void xcd_barrier_complete(unsigned* bar, unsigned x, unsigned& nloc, unsigned& nx) {
    const unsigned G = gridDim.x * gridDim.y * gridDim.z;
    unsigned sum, cnt, mine, sp = 0u;
    for (;;) {
        sum = 0u; cnt = 0u; mine = 0u;
#pragma unroll
        for (unsigned j = 0; j < 16; ++j) { const unsigned c = xb_ld(&bar[XB_XCNT(j)]); sum += c; cnt += (c > 0u) ? 1u : 0u; mine = (j == x) ? c : mine; }
        if (sum == G) break;
        __builtin_amdgcn_s_sleep(1);
        if ((++sp & 255u) == 0u) { if (xb_ld(&bar[XB_TMO])) break; if (sp > XB_SPIN_CAP) { atomicAdd(&bar[XB_TMO], 1u); break; } }
    }
    nloc = mine > 0u ? mine : 1u; nx = cnt > 0u ? cnt : 1u;
}
__device__ __forceinline__ void xcd_barrier(const XcdBarrier& b) {
    asm volatile("s_waitcnt vmcnt(0)" ::: "memory");
    __syncthreads();
    if (threadIdx.x == 0) {
        unsigned* bar = b.bar;
        __builtin_amdgcn_s_waitcnt(0);
        unsigned nloc = b.st[0], nx = b.st[1];
        if (nloc == 0u) { xcd_barrier_complete(bar, b.x, nloc, nx); b.st[0] = nloc; b.st[1] = nx; }
        const unsigned old = xb_add(&bar[XB_XSUB(b.x)], 1u);
        const unsigned gen = old / nloc;
        if (old + 1u == (gen + 1u) * nloc) {
            __builtin_amdgcn_fence(__ATOMIC_RELEASE, "agent");
            asm volatile("s_waitcnt vmcnt(0)" ::: "memory");
            const unsigned og = xb_add(&bar[XB_TOP], 1u);
            const unsigned tg = og / nx;
            if (og + 1u == (tg + 1u) * nx) xb_add(&bar[XB_TOPGEN], 1u);
            else XB_SPIN(xb_ld(&bar[XB_TOPGEN]) == tg, bar);
            __builtin_amdgcn_fence(__ATOMIC_ACQUIRE, "agent");
            xb_add(&bar[XB_XGEN(b.x)], 1u);
            asm volatile("s_waitcnt vmcnt(0)" ::: "memory");
        } else {
            XB_SPIN(xb_ld(&bar[XB_XGEN(b.x)]) == gen, bar);
            __builtin_amdgcn_fence(__ATOMIC_ACQUIRE, "agent");
            asm volatile("s_waitcnt vmcnt(0)" ::: "memory");
        }
    }
    __syncthreads();
}

__device__ __forceinline__ void pg8::OrderMoe::unit_sync() const { if (gb_bar) { XcdBarrier b; b.bar = gb_bar; b.x = gb_x; b.st = gb_st; xcd_barrier(b); } }
constexpr int NWAVES = 8;
constexpr int RING_BYTES = 131072, LDS_BYTES = 147456, MISC_OFF = LDS_BYTES - 256;
struct Args { const float* in[31]; float* out; unsigned char* ws; int ph_lo, ph_hi, probe, breg; };
enum { I_X = 0, I_POS, I_NMIX, I_NFFN, I_NFIN, I_S5WIN, I_LRE, I_LIM, I_LDT, I_BRE, I_BIM, I_CRE, I_CIM, I_S5D, I_S5WGLU, I_S5WOUT, I_KVNORM, I_WDKV, I_KVLN, I_WUKV, I_WDQ, I_QLN, I_WUQ, I_WO,
       I_FG, I_FU, I_FD, I_ROUTER, I_MG, I_MU, I_MD };
struct Frame { LAS unsigned char* lds; int tid, lane, wave, vcu, G; unsigned char* ws; };
#define FRESH_IDS(F) do { int t_ = threadIdx.x; asm volatile("" : "+v"(t_)); (F).tid = t_; (F).lane = t_ & 63; } while (0)
__device__ __forceinline__ const float* karg_in(int i) {
    auto kp = __builtin_amdgcn_kernarg_segment_ptr(); unsigned long long v;
    asm volatile("s_load_dwordx2 %0, %1, %2\n\ts_waitcnt lgkmcnt(0)" : "=s"(v) : "s"(kp), "i"(i * 8));
    return (const float*)v;
}
#define KIN(i) karg_in(i)

__device__ __forceinline__ void tr_block64(const float* W, int ldw, int k0, int n0, int nvalid, const float* gain, bf16* WT, int ldt, int dr0, int dr1, LAS float* scr, int lane) {
    const int r = lane >> 4, c4 = lane & 15; f32x4 v[16];
    const bool ok = 4 * c4 < nvalid;
#pragma unroll
    for (int i = 0; i < 16; ++i) v[i] = ok ? *(const f32x4*)(W + (size_t)(k0 + 4 * i + r) * ldw + n0 + 4 * c4) : (f32x4){0.f, 0.f, 0.f, 0.f};
    if (gain) {
#pragma unroll
        for (int i = 0; i < 16; ++i) v[i] = v[i] * gain[k0 + 4 * i + r]; }
#pragma unroll
    for (int i = 0; i < 16; ++i) { LAS float* d = scr + (4 * i + r) * 65 + 4 * c4; d[0] = v[i][0]; d[1] = v[i][1]; d[2] = v[i][2]; d[3] = v[i][3]; }
    LDS_WAIT(); asm volatile("" ::: "memory");
    const int kc = lane & 7, nr = lane >> 3;
#pragma unroll
    for (int j = 0; j < 8; ++j) { const int n = 8 * j + nr; const LAS float* s = scr + (8 * kc) * 65 + n;
        u32x4 o; o.x = cvt_pk_bf16(s[0 * 65], s[1 * 65]); o.y = cvt_pk_bf16(s[2 * 65], s[3 * 65]); o.z = cvt_pk_bf16(s[4 * 65], s[5 * 65]); o.w = cvt_pk_bf16(s[6 * 65], s[7 * 65]);
        if (n < nvalid) *(u32x4*)(WT + (size_t)(n < 32 ? dr0 + n : dr1 + n - 32) * ldt + k0 + 8 * kc) = o; }
    LDS_WAIT(); asm volatile("" ::: "memory");
}
__device__ __forceinline__ void tr_block64_f8(const float* W, int ldw, int k0, int n0, const float* gain, float scale, unsigned char* WT8, int ldt, int dr0, int dr1, LAS float* scr, int lane) {
    const int r = lane >> 4, c4 = lane & 15; f32x4 v[16];
#pragma unroll
    for (int i = 0; i < 16; ++i) v[i] = *(const f32x4*)(W + (size_t)(k0 + 4 * i + r) * ldw + n0 + 4 * c4);
#pragma unroll
    for (int i = 0; i < 16; ++i) v[i] = v[i] * (gain ? gain[k0 + 4 * i + r] * scale : scale);
#pragma unroll
    for (int i = 0; i < 16; ++i) { LAS float* d = scr + (4 * i + r) * 65 + 4 * c4; d[0] = v[i][0]; d[1] = v[i][1]; d[2] = v[i][2]; d[3] = v[i][3]; }
    LDS_WAIT(); asm volatile("" ::: "memory");
    const int kc = lane & 7, nr = lane >> 3;
#pragma unroll
    for (int j = 0; j < 8; ++j) { const int n = 8 * j + nr; const LAS float* s = scr + (8 * kc) * 65 + n;
        const u32x2 o = (u32x2){pack4_fp8((f32x4){s[0 * 65], s[1 * 65], s[2 * 65], s[3 * 65]}), pack4_fp8((f32x4){s[4 * 65], s[5 * 65], s[6 * 65], s[7 * 65]})};
        *(u32x2*)(WT8 + (size_t)(n < 32 ? dr0 + n : dr1 + n - 32) * ldt + k0 + 8 * kc) = o; }
    LDS_WAIT(); asm volatile("" ::: "memory");
}
template <int MAP> __device__ __forceinline__ void tr_item_f8(const float* W, int K, int N, const float* gain, float scale, unsigned char* WT8, int ldt, int row_off, LAS float* scr, int it, int lane);
enum { MAP_PLAIN = 0, MAP_GU_GATE, MAP_GU_UP, MAP_DKV, MAP_UKV, MAP_UQ };
template <int MAP> __device__ __forceinline__ int map_row(int n0, int row_off) {
    if (MAP == MAP_PLAIN) return row_off + n0;
    if (MAP == MAP_GU_GATE) return row_off + 256 * (n0 >> 7) + (n0 & 127);
    if (MAP == MAP_GU_UP) return row_off + 256 * (n0 >> 7) + 128 + (n0 & 127);
    if (MAP == MAP_DKV) return n0 < 256 ? n0 : 768 + (n0 - 256);
    if (MAP == MAP_UKV) { const int h = n0 >> 7, w = n0 & 127; return w < 64 ? h * 64 + w : 1024 + h * 64 + (w - 64); }
    { const int h = n0 / 96, w = n0 % 96; return w < 64 ? h * 64 + w : 1024 + h * 32 + (w - 64); }
}
template <int MAP> __device__ __forceinline__ void tr_item(const float* W, int K, int N, const float* gain, bf16* WT, int ldt, int row_off, LAS float* scr, int it, int lane) {
    const int nblk = (N + 63) / 64, kb = it / nblk, nb = it % nblk, n0 = 64 * nb; const int nvalid = (N - n0) < 64 ? (N - n0) : 64;
    tr_block64(W, N, 64 * kb, n0, nvalid, gain, WT, ldt, map_row<MAP>(n0, row_off), map_row<MAP>(n0 + 32, row_off), scr, lane);
}

template <int MAP> __device__ __forceinline__ void tr_item_f8(const float* W, int K, int N, const float* gain, float scale, unsigned char* WT8, int ldt, int row_off, LAS float* scr, int it, int lane) {
    const int nblk = N / 128, kb = it / nblk, nb = it % nblk, k0 = 128 * kb, n0 = 128 * nb;
    LAS unsigned* T = (LAS unsigned*)scr; const int kr = lane >> 5, c4 = lane & 31;
#pragma unroll 1
    for (int bt = 0; bt < 4; ++bt) {
        f32x4 v[4][4];
#pragma unroll
        for (int s = 0; s < 4; ++s)
#pragma unroll
            for (int kk = 0; kk < 4; ++kk) v[s][kk] = *(const f32x4*)(W + (size_t)(k0 + 4 * (8 * bt + 2 * s + kr) + kk) * N + n0 + 4 * c4);
#pragma unroll
        for (int s = 0; s < 4; ++s) { const int kq = 8 * bt + 2 * s + kr; float gsc[4];
#pragma unroll
            for (int kk = 0; kk < 4; ++kk) gsc[kk] = gain ? gain[k0 + 4 * kq + kk] * scale : scale;
#pragma unroll
            for (int c = 0; c < 4; ++c) T[(4 * c4 + c) * 33 + kq] = pack4_fp8((f32x4){v[s][0][c] * gsc[0], v[s][1][c] * gsc[1], v[s][2][c] * gsc[2], v[s][3][c] * gsc[3]}); }
    }
    LDS_WAIT(); asm volatile("" ::: "memory");
    const int kc = lane & 7, nr = lane >> 3;
#pragma unroll
    for (int j = 0; j < 16; ++j) { const int n = 8 * j + nr; const LAS unsigned* s = T + n * 33 + 4 * kc;
        const u32x4 o = (u32x4){s[0], s[1], s[2], s[3]};
        *(u32x4*)(WT8 + (size_t)map_row<MAP>(n0 + (n & ~31), row_off) * ldt + (size_t)(n & 31) * ldt + k0 + 16 * kc) = o; }
    LDS_WAIT(); asm volatile("" ::: "memory");
}
__device__ __forceinline__ void sincos_red(double r, double& s, double& c) {
    const double r2 = r * r; double ss = 1.0, cc = 1.0;
#pragma unroll
    for (int k = 13; k >= 1; --k) { ss = 1.0 - ss * r2 * (1.0 / (double)((2 * k) * (2 * k + 1))); cc = 1.0 - cc * r2 * (1.0 / (double)((2 * k - 1) * (2 * k))); }
    s = r * ss; c = cc;
}
__device__ __forceinline__ void sincos_d(double a, double& s, double& c) {
    const double k = __builtin_rint(a * 0.15915494309189535); const double r = (a - k * 6.283185307179586) - k * 2.4492935982947064e-16;
    sincos_red(r, s, c);
}

__device__ __forceinline__ void xb_batch(const float* x, bf16* XB, float* ST, int m0, int lane) {
    f32x4 v[4][4]; float s[4];
#pragma unroll
    for (int a = 0; a < 4; ++a) { const f32x4* xr = (const f32x4*)(x + (size_t)(m0 + a) * DM) + lane;
#pragma unroll
        for (int j = 0; j < 4; ++j) v[a][j] = xr[64 * j]; }
#pragma unroll
    for (int a = 0; a < 4; ++a) { s[a] = 0.f;
#pragma unroll
        for (int j = 0; j < 4; ++j) s[a] += (v[a][j][0] * v[a][j][0] + v[a][j][1] * v[a][j][1]) + (v[a][j][2] * v[a][j][2] + v[a][j][3] * v[a][j][3]);
        s[a] = wave_sum(s[a]); }
#pragma unroll
    for (int a = 0; a < 4; ++a) { const int m = m0 + a; u32x2* o8 = (u32x2*)(XB + (size_t)m * DM) + lane;
#pragma unroll
        for (int j = 0; j < 4; ++j) o8[64 * j] = (u32x2){cvt_pk_bf16(v[a][j][0], v[a][j][1]), cvt_pk_bf16(v[a][j][2], v[a][j][3])};
        if (lane < 16) ST[(size_t)m * 16 + lane] = lane == 0 ? s[a] : 0.f; }
}
__device__ __forceinline__ void p0_s5_tables(Frame& F, const Args& A, bool xb_early) {
    FRESH_IDS(F);
    LAS float* L = (LAS float*)F.lds;
    constexpr int CS = 68, KS = 272;
    LAS float* AP2 = L; LAS float* BBR = L + 33 * 64 * 2; LAS float* BBI = BBR + 1024; LAS float* CR = BBI + 1024; LAS float* CI = CR + 16 * CS; LAS float* KD = CI + 16 * CS;
    bf16* BT4 = (bf16*)(F.ws + WS_BT4); bf16* WEND = (bf16*)(F.ws + WS_WEND); float* A32 = (float*)(F.ws + WS_A32);
    const int t = F.tid;
    for (int item = F.vcu; item < SG * 4; item += F.G) {
        const int g = item >> 2, q = item & 3;
        if (t < 64) {
            const int p = t; const float* bre = KIN(I_BRE) + (size_t)(g * 64 + p) * 16; const float* bim = KIN(I_BIM) + (size_t)(g * 64 + p) * 16;
            f32x4 br4[4], bi4[4];
#pragma unroll
            for (int k = 0; k < 4; ++k) { br4[k] = *(const f32x4*)(bre + 4 * k); bi4[k] = *(const f32x4*)(bim + 4 * k); }
            const double dt = exp((double)KIN(I_LDT)[g]); const double lr = (double)KIN(I_LRE)[g * 64 + p], li = (double)KIN(I_LIM)[g * 64 + p];
            const double mag = exp(lr * dt); double s1, c1; sincos_d(li * dt, s1, c1);
            const double ar = mag * c1, ai = mag * s1, den = lr * lr + li * li, nr = ar - 1.0, ni = ai;
            const double cfr = (nr * lr + ni * li) / den, cfi = (ni * lr - nr * li) / den;
            double pr = 1.0, pi = 0.0;
            for (int l = 0; l <= 32; ++l) { AP2[(l * 64 + p) * 2] = (float)pr; AP2[(l * 64 + p) * 2 + 1] = (float)pi; const double nr2 = pr * ar - pi * ai, ni2 = pr * ai + pi * ar; pr = nr2; pi = ni2; }
            if (q == 0) { A32[(g * 64 + p) * 2] = AP2[(32 * 64 + p) * 2]; A32[(g * 64 + p) * 2 + 1] = AP2[(32 * 64 + p) * 2 + 1]; }
#pragma unroll
            for (int m = 0; m < 16; ++m) { const double br = (double)br4[m >> 2][m & 3], bi = (double)bi4[m >> 2][m & 3];
                BBR[p * 16 + m] = (float)(cfr * br - cfi * bi); BBI[p * 16 + m] = (float)(cfr * bi + cfi * br); }
        }
        else if (xb_early && item == F.vcu) {
            const float* x = KIN(I_X); bf16* XB = (bf16*)(F.ws + WS_XB); float* ST = (float*)(F.ws + WS_ST);
            xb_batch(x, XB, ST, 128 * F.vcu + 4 * (F.wave - 1), F.lane); xb_batch(x, XB, ST, 128 * F.vcu + 4 * (F.wave + 6), F.lane); }
        { const float* cre = KIN(I_CRE) + (size_t)g * 1024; const float* cim = KIN(I_CIM) + (size_t)g * 1024;
          for (int e = t; e < 1024; e += 512) { const int n = e >> 6, p = e & 63; CR[n * CS + p] = cre[e]; CI[n * CS + p] = cim[e]; } }
        __syncthreads();
        { const int lo = F.lane & 15, kk = F.lane >> 4, ph = kk >> 1, c = kk & 1;
          float P[32], Q[32], Bv[32];
#pragma unroll
          for (int s = 0; s < 32; ++s) { const int p = 2 * s + ph; const float cr = CR[lo * CS + p], ci = CI[lo * CS + p]; P[s] = c ? -ci : cr; Q[s] = c ? -cr : -ci; Bv[s] = c ? BBI[p * 16 + lo] : BBR[p * 16 + lo]; }
          f32x4 acc[4];
#pragma unroll
          for (int j = 0; j < 4; ++j) acc[j] = (f32x4){0.f, 0.f, 0.f, 0.f};
          const LAS float* apw = AP2 + (4 * F.wave * 64 + ph) * 2;
#pragma unroll
          for (int s = 0; s < 32; ++s) {
#pragma unroll
              for (int j = 0; j < 4; ++j) { const f32x2 ap = *(const LAS f32x2*)(apw + (j * 64 + 2 * s) * 2); const float a = P[s] * ap[0] + Q[s] * ap[1];
                  acc[j] = __builtin_amdgcn_mfma_f32_16x16x4f32(a, Bv[s], acc[j], 0, 0, 0); } }
          const float dsk = KIN(I_S5D)[g * 16 + lo];
#pragma unroll
          for (int j = 0; j < 4; ++j) { const int l = 4 * F.wave + j;
#pragma unroll
              for (int r = 0; r < 4; ++r) { const int n = 4 * kk + r; float v = acc[j][r]; if (l == 0 && n == lo) v += dsk; KD[l * KS + n * 16 + lo] = v; } } }
        __syncthreads();
#pragma unroll 2
        for (int piece = t; piece < 128 * 64; piece += 512) {
            const int rl = piece >> 6, pc = piece & 63, i = 8 * q + (rl >> 4), n = rl & 15, j = pc >> 1, m0 = (pc & 1) * 8, lag = i - j;
            const LAS f32x4* kp = (const LAS f32x4*)(KD + (lag < 0 ? 0 : lag) * KS + n * 16 + m0);
            f32x4 v0 = kp[0], v1 = kp[1]; if (lag < 0) { v0 = (f32x4){0.f, 0.f, 0.f, 0.f}; v1 = v0; }
            *(u32x4*)(BT4 + ((size_t)g * 512 + 128 * q + rl) * UGLD + UC0 + pc * 8) = pack8(v0, v1);
        }
#pragma unroll 2
        for (int piece = t; piece < 128 * 16; piece += 512) {
            const int rl = piece >> 4, pcb = piece & 15, i = 8 * q + (rl >> 4), n = rl & 15, ri = pcb >> 3, p0 = (pcb & 7) * 8;
            const LAS f32x4* cr4 = (const LAS f32x4*)(CR + n * CS + p0); const LAS f32x4* ci4 = (const LAS f32x4*)(CI + n * CS + p0); const LAS f32x4* ap4 = (const LAS f32x4*)(AP2 + ((i + 1) * 64 + p0) * 2);
            const f32x4 c0 = cr4[0], c1 = cr4[1], d0 = ci4[0], d1 = ci4[1], a0 = ap4[0], a1 = ap4[1], a2 = ap4[2], a3 = ap4[3];
            const f32x4 ar0 = (f32x4){a0[0], a0[2], a1[0], a1[2]}, ai0 = (f32x4){a0[1], a0[3], a1[1], a1[3]}, ar1 = (f32x4){a2[0], a2[2], a3[0], a3[2]}, ai1 = (f32x4){a2[1], a2[3], a3[1], a3[3]};
            f32x4 v0, v1; if (ri == 0) { v0 = c0 * ar0 - d0 * ai0; v1 = c1 * ar1 - d1 * ai1; } else { v0 = -(c0 * ai0 + d0 * ar0); v1 = -(c1 * ai1 + d1 * ar1); }
            *(u32x4*)(BT4 + ((size_t)g * 512 + 128 * q + rl) * UGLD + pcb * 8) = pack8(v0, v1);
        }
#pragma unroll 2
        for (int piece = t; piece < 32 * 64; piece += 512) {
            const int rl = piece >> 6, pc = piece & 63, qq = 32 * q + rl, ri = qq >> 6, p = qq & 63, j = pc >> 1, m0 = (pc & 1) * 8, l = 31 - j;
            const f32x2 ap = *(const LAS f32x2*)(AP2 + (l * 64 + p) * 2); const LAS f32x4* br4 = (const LAS f32x4*)(BBR + p * 16 + m0); const LAS f32x4* bi4 = (const LAS f32x4*)(BBI + p * 16 + m0);
            const f32x4 b0 = br4[0], b1 = br4[1], e0 = bi4[0], e1 = bi4[1];
            f32x4 v0, v1; if (ri == 0) { v0 = b0 * ap[0] - e0 * ap[1]; v1 = b1 * ap[0] - e1 * ap[1]; } else { v0 = e0 * ap[0] + b0 * ap[1]; v1 = e1 * ap[0] + b1 * ap[1]; }
            *(u32x4*)(WEND + ((size_t)g * 256 + qq) * UK + pc * 8) = pack8(v0, v1);
        }
        __syncthreads();
    }
}
constexpr int SW_SQ = 16 * 16, SW_FGU = 16 * 42, SW_FDN = 21 * 8, SW_DKV = 16 * 5, SW_DQ = 16 * 8, SW_UKV = 4 * 32, SW_UQ = 8 * 24;
constexpr int SW_EARLY = 3 * SW_SQ + 2 * SW_FGU, SW_ALL = SW_EARLY + SW_FDN + SW_DKV + SW_DQ + SW_UKV + SW_UQ + SW_SQ;
__device__ __forceinline__ void small_weights(Frame& F, int it0, int it1, int gw, int NGW) {
    FRESH_IDS(F);
    unsigned char* ws = F.ws; LAS float* scr = (LAS float*)(F.lds + F.wave * 16896);
    constexpr int I_SQ = SW_SQ, I_FGU = SW_FGU, I_FDN = SW_FDN, I_DKV = SW_DKV, I_DQ = SW_DQ, I_UKV = SW_UKV, I_UQ = SW_UQ;
    for (int it = it0 + gw; it < it1; it += NGW) {
        int r = it;
        if (r < I_SQ) { tr_item<MAP_PLAIN>(KIN(I_S5WIN), DM, DM, KIN(I_NMIX), (bf16*)(ws + WS_WIN), DM, 0, scr, r, F.lane); continue; } r -= I_SQ;
        if (r < I_SQ) { tr_item<MAP_PLAIN>(KIN(I_S5WGLU), DM, DM, nullptr, (bf16*)(ws + WS_WGLU), DM, 0, scr, r, F.lane); continue; } r -= I_SQ;
        if (r < I_SQ) { tr_item<MAP_PLAIN>(KIN(I_S5WOUT), DM, DM, nullptr, (bf16*)(ws + WS_WOUT), DM, 0, scr, r, F.lane); continue; } r -= I_SQ;
        if (r < I_FGU) { tr_item<MAP_GU_GATE>(KIN(I_FG), DM, DFF, KIN(I_NFFN), (bf16*)(ws + WS_WGU), DM, 0, scr, r, F.lane); continue; } r -= I_FGU;
        if (r < I_FGU) { tr_item<MAP_GU_UP>(KIN(I_FU), DM, DFF, KIN(I_NFFN), (bf16*)(ws + WS_WGU), DM, 0, scr, r, F.lane); continue; } r -= I_FGU;
        if (r < I_FDN) { tr_item_f8<MAP_PLAIN>(KIN(I_FD), DFF, DM, nullptr, FS_W, ws + WS_WDOWN, H8LD, 0, scr, r, F.lane); continue; } r -= I_FDN;
        if (r < I_DKV) { tr_item<MAP_DKV>(KIN(I_WDKV), DM, KVL + DROPE, KIN(I_KVNORM), (bf16*)(ws + WS_WKVQ), DM, 0, scr, r, F.lane); continue; } r -= I_DKV;
        if (r < I_DQ) { tr_item<MAP_PLAIN>(KIN(I_WDQ), DM, QL, KIN(I_NMIX) + DM, (bf16*)(ws + WS_WKVQ), DM, 256, scr, r, F.lane); continue; } r -= I_DQ;
        if (r < I_UKV) { tr_item<MAP_UKV>(KIN(I_WUKV), KVL, 2048, KIN(I_KVLN), (bf16*)(ws + WS_WUKV), KVL, 0, scr, r, F.lane); continue; } r -= I_UKV;
        if (r < I_UQ) { tr_item<MAP_UQ>(KIN(I_WUQ), QL, 1536, KIN(I_QLN), (bf16*)(ws + WS_WUQ), QL, 0, scr, r, F.lane); continue; } r -= I_UQ;
        tr_item<MAP_PLAIN>(KIN(I_WO), DM, DM, nullptr, (bf16*)(ws + WS_WO), DM, 0, scr, r, F.lane);
    }
}
__device__ __forceinline__ void late_tables(Frame& F, int rank, int cnt) {
    FRESH_IDS(F);
    unsigned char* ws = F.ws;
    for (int e = rank * 512 + F.tid; e < DM * 8; e += cnt * 512) *(u32x4*)(ws + WS_WDOWN + (size_t)(e >> 3) * H8LD + DFF + (e & 7) * 16) = (u32x4){0u, 0u, 0u, 0u};
    { const int* pos = (const int*)KIN(I_POS); float* COS = (float*)(ws + WS_COS); float* SIN = (float*)(ws + WS_SIN);
      for (int e = rank * 512 + F.tid; e < M * 16; e += cnt * 512) { const int row = e >> 4, c = e & 15;
          const int c4 = c & 3, c16 = c >> 2;
          const double b4 = c4 == 0 ? 1.0 : (c4 == 1 ? 0.5623413251903491 : (c4 == 2 ? 0.31622776601683794 : 0.1778279410038923));
          const double sc = c16 == 0 ? 1.0 : (c16 == 1 ? 0.1 : (c16 == 2 ? 0.01 : 0.001));
          double s, cc; sincos_d((double)pos[row] * (b4 * sc), s, cc); COS[e] = (float)cc; SIN[e] = (float)s; } }
    { bf16* RWB = (bf16*)(ws + WS_ROUTW); const float* rw = KIN(I_ROUTER); const float* gn = KIN(I_NFFN) + DM;
      for (int e = rank * 512 + F.tid; e < 32 * 64 * 8; e += cnt * 512) { const int k8 = e & 7, ln = (e >> 3) & 63, s = e >> 9, i = ln & 15, k = 32 * s + 8 * (ln >> 4) + k8;
          const float w = i < NE ? rw[k * NE + i] * gn[k] : 0.f;
          const unsigned h = cvt_pk_bf16(w, 0.f) & 0xffffu; const float r1 = w - u2f(h << 16); const unsigned m = cvt_pk_bf16(r1, 0.f) & 0xffffu; const float r2 = r1 - u2f(m << 16); const unsigned l = cvt_pk_bf16(r2, 0.f) & 0xffffu;
          RWB[e] = (bf16)h; RWB[32 * 64 * 8 + e] = (bf16)m; RWB[2 * 32 * 64 * 8 + e] = (bf16)l; } }
}
__device__ __forceinline__ void p0_prologue(Frame& F, const Args& A) {
    FRESH_IDS(F);
    unsigned char* ws = F.ws;
    const bool fast = F.G == 256;
    p0_s5_tables(F, A, fast);
    __syncthreads();
    const int gw = F.vcu * NWAVES + F.wave, NGW = F.G * NWAVES;
    if (fast) { small_weights(F, 0, NGW < SW_EARLY ? NGW : SW_EARLY, gw, NGW);
        if (F.wave == 2 && (F.vcu & 3) == 0) small_weights(F, NGW + (F.vcu >> 2), SW_EARLY, 0, NGW); }
    else small_weights(F, 0, SW_ALL, gw, NGW);
    { const float* x = KIN(I_X); bf16* XB = (bf16*)(ws + WS_XB); float* ST = (float*)(ws + WS_ST);
      if (fast) { for (int bi = 14 + F.wave; bi < 32; bi += NWAVES) xb_batch(x, XB, ST, 128 * F.vcu + 4 * bi, F.lane); }
      else { for (int m0 = gw * 4; m0 < M; m0 += NGW * 4) xb_batch(x, XB, ST, m0, F.lane); } }
    if (!fast) late_tables(F, F.vcu, F.G);
}

__device__ __forceinline__ void scan_panel(Frame& F, int g, int pm) {
    FRESH_IDS(F);
    const int p = F.lane, line = F.wave >> 2, seg = F.wave & 3, b = 2 * pm + line;
    const float* E = (const float*)(F.ws + WS_E); bf16* UG = (bf16*)(F.ws + WS_UG); const float* A32 = (const float*)(F.ws + WS_A32);
    LAS float* XF_ = (LAS float*)F.lds;
    const float ar = A32[(g * 64 + p) * 2], ai = A32[(g * 64 + p) * 2 + 1];
    const size_t row0 = (size_t)g * BC + b * NCH + seg * 32;
    float er[32], ei[32];
#pragma unroll
    for (int k = 0; k < 32; ++k) { er[k] = E[(row0 + k) * 128 + p]; ei[k] = E[(row0 + k) * 128 + 64 + p]; }
    float lr = 0.f, li = 0.f;
#pragma unroll
    for (int k = 0; k < 32; ++k) { const float tr = er[k], ti = ei[k]; er[k] = lr; ei[k] = li; const float nr = ar * lr - ai * li + tr, ni = ar * li + ai * lr + ti; lr = nr; li = ni; }
    XF_[((line * 4 + seg) * 2 + 0) * 64 + p] = lr; XF_[((line * 4 + seg) * 2 + 1) * 64 + p] = li;
    float sr = ar, si = ai;
#pragma unroll
    for (int q = 0; q < 5; ++q) { const float nr = sr * sr - si * si, ni = 2.f * sr * si; sr = nr; si = ni; }
    __syncthreads();
    float cr = 0.f, ci = 0.f;
    for (int k = 0; k < seg; ++k) { const float fr = XF_[((line * 4 + k) * 2 + 0) * 64 + p], fi = XF_[((line * 4 + k) * 2 + 1) * 64 + p]; const float nr = sr * cr - si * ci + fr, ni = sr * ci + si * cr + fi; cr = nr; ci = ni; }
    float pr = cr, pi = ci;
#pragma unroll
    for (int k = 0; k < 32; ++k) { bf16* d = UG + (row0 + k) * UGLD; d[p] = (bf16)(cvt_pk_bf16(er[k] + pr, 0.f) & 0xffffu); d[64 + p] = (bf16)(cvt_pk_bf16(ei[k] + pi, 0.f) & 0xffffu);
        const float nr = ar * pr - ai * pi, ni = ar * pi + ai * pr; pr = nr; pi = ni; }
}

__device__ __forceinline__ void p14_router(Frame& F, const Args& A) {
    FRESH_IDS(F);
    unsigned char* ws = F.ws;
    const bf16* XB = (const bf16*)(ws + WS_XB); u32x4* TOK = (u32x4*)(ws + WS_TOK); int* CNT = (int*)(ws + WS_CNT);
    const int gw = F.vcu * NWAVES + F.wave, NGW = F.G * NWAVES;
    for (int chunk = gw; chunk < M / 16; chunk += NGW) {
        f32x4 ah = (f32x4){0.f, 0.f, 0.f, 0.f}, am = ah, al = ah, as = ah;
        const bf16* xrow = XB + (size_t)(chunk * 16 + (F.lane & 15)) * DM + 8 * (F.lane >> 4); const bf16x8* wl = (const bf16x8*)(ws + WS_ROUTW) + F.lane;
#pragma unroll 1
        for (int hf = 0; hf < 2; ++hf) {
            bf16x8 xf[16];
#pragma unroll
            for (int s = 0; s < 16; ++s) xf[s] = *(const bf16x8*)(xrow + 32 * (16 * hf + s));
#pragma unroll
            for (int gq = 0; gq < 2; ++gq) {
                bf16x8 wf[3][8];
#pragma unroll
                for (int s = 0; s < 8; ++s) { const int ss = 16 * hf + 8 * gq + s; wf[0][s] = wl[ss * 64]; wf[1][s] = wl[(32 + ss) * 64]; wf[2][s] = wl[(64 + ss) * 64]; }
                __builtin_amdgcn_sched_barrier(0);
#pragma unroll
                for (int s = 0; s < 8; ++s) { const bf16x8 xs = xf[8 * gq + s];
                    ah = __builtin_amdgcn_mfma_f32_16x16x32_bf16(wf[0][s], xs, ah, 0, 0, 0); am = __builtin_amdgcn_mfma_f32_16x16x32_bf16(wf[1][s], xs, am, 0, 0, 0);
                    al = __builtin_amdgcn_mfma_f32_16x16x32_bf16(wf[2][s], xs, al, 0, 0, 0); as = __builtin_amdgcn_mfma_f32_16x16x32_bf16(xs, xs, as, 0, 0, 0); }
                __builtin_amdgcn_sched_barrier(0); }
        }
        const int tk_ = F.lane & 15, g_ = F.lane >> 4;
        const float dg = (tk_ & 3) == 0 ? as[0] : ((tk_ & 3) == 1 ? as[1] : ((tk_ & 3) == 2 ? as[2] : as[3]));
        const float ssq = __shfl(dg, (tk_ >> 2) * 16 + tk_); const float rs = rsqrtf(ssq * (1.0f / DM) + EPS);
        float own[4], oth[4], lg[8];
#pragma unroll
        for (int r = 0; r < 4; ++r) { own[r] = ((ah[r] + am[r]) + al[r]) * rs; auto sw = __builtin_amdgcn_permlane16_swap(__float_as_uint(own[r]), __float_as_uint(own[r]), false, false); oth[r] = __uint_as_float((g_ & 1) ? sw[0] : sw[1]); }
#pragma unroll
        for (int r = 0; r < 4; ++r) { lg[r] = (g_ & 1) ? oth[r] : own[r]; lg[4 + r] = (g_ & 1) ? own[r] : oth[r]; }
        int e0 = 0; float l0 = lg[0];
#pragma unroll
        for (int e = 1; e < 8; ++e) if (lg[e] > l0) { l0 = lg[e]; e0 = e; }
        int e1 = -1; float l1 = -INFINITY;
#pragma unroll
        for (int e = 0; e < 8; ++e) if (e != e0 && lg[e] > l1) { l1 = lg[e]; e1 = e; }
        const float w1 = 1.0f / (1.0f + expf(l0 - l1)), w0 = 1.0f - w1;
        const int me0 = e0, me1 = e1; const float mw0 = w0, mw1 = w1, mrs = rs;
        int r0 = 0, r1 = 0, mycnt = 0; const bool act = F.lane < 16;
#pragma unroll
        for (int e = 0; e < 8; ++e) { const unsigned long long mk = __ballot(act && (me0 == e || me1 == e)); const int rk = __popcll(mk & ((1ull << F.lane) - 1ull));
            if (act && me0 == e) r0 = rk; if (act && me1 == e) r1 = rk; if (F.lane == e) mycnt = __popcll(mk); }
        if (act) TOK[chunk * 16 + F.lane] = (u32x4){(unsigned)me0 | ((unsigned)me1 << 8) | ((unsigned)r0 << 16) | ((unsigned)r1 << 24), __builtin_bit_cast(unsigned, mw0), __builtin_bit_cast(unsigned, mw1), __builtin_bit_cast(unsigned, mrs)};
        if (F.lane < 8) CNT[chunk * 8 + F.lane] = mycnt;
    }
}

__device__ __forceinline__ void moe_weight_convert(Frame& F, unsigned char* wm, int rank, int nconv) {
    FRESH_IDS(F);
    unsigned char* ws = F.ws;
    LAS float* scr = (LAS float*)(F.lds + F.wave * 16896);
    constexpr int I_G = 8 * 28, I_D = 28 * 8, PER_E = 2 * I_G + I_D;
    const float* gn = KIN(I_NFFN) + DM; const int gw = rank * NWAVES + F.wave, NGW = nconv * NWAVES;
    for (int it = gw; it < NE * PER_E; it += NGW) {
        const int e = it / PER_E; int r = it % PER_E;
        if (r < I_G) { tr_item_f8<MAP_GU_GATE>(KIN(I_MG) + (size_t)e * DM * MFF, DM, MFF, gn, FS_W, wm + OUT_WMGU, DM, e * NMGU, scr, r, F.lane); continue; } r -= I_G;
        if (r < I_G) { tr_item_f8<MAP_GU_UP>(KIN(I_MU) + (size_t)e * DM * MFF, DM, MFF, gn, FS_W, wm + OUT_WMGU, DM, e * NMGU, scr, r, F.lane); continue; } r -= I_G;
        tr_item_f8<MAP_PLAIN>(KIN(I_MD) + (size_t)e * MFF * DM, MFF, DM, nullptr, FS_W, wm + OUT_WMDN, MFF, e * DM, scr, r, F.lane);
    }
}

__device__ __forceinline__ void p15_scatter(Frame& F, const Args& A) {
    FRESH_IDS(F);
    unsigned char* ws = F.ws; const int* CNT = (const int*)(ws + WS_CNT); int* MINFO = (int*)(ws + WS_MINFO);
    LAS int* LI = (LAS int*)F.lds;
    if (F.tid < 32) LI[F.tid] = 0;
    __syncthreads();
    const int NCHUNK = M / 16, gw0 = F.vcu * NWAVES;
    for (int pass = 0; pass * F.G * NWAVES < NCHUNK; ++pass) {
        const int cbase = pass * F.G * NWAVES + gw0;
        const int chunk = cbase + F.wave; const bool actc = chunk < NCHUNK;
        const u32x4* TOK = (const u32x4*)(ws + WS_TOK); const bf16* XB = (const bf16*)(ws + WS_XB);
        u32x4 tk = (u32x4){0u, 0u, 0u, 0u}; int cw[7]; u32x4 v[4][2];
#pragma unroll
        for (int w = 0; w < 7; ++w) cw[w] = 0;
        if (actc) { if (F.lane < 16) tk = TOK[chunk * 16 + F.lane];
            if (F.lane < 8) {
#pragma unroll
                for (int w = 0; w < 7; ++w) cw[w] = (w < F.wave) ? CNT[(cbase + w) * 8 + F.lane] : 0; }
#pragma unroll
            for (int a = 0; a < 4; ++a) { const u32x4* xr = (const u32x4*)(XB + (size_t)(chunk * 16 + a) * DM) + 2 * F.lane; v[a][0] = xr[0]; v[a][1] = xr[1]; } }
        __syncthreads();
        if (F.tid < 16) LI[F.tid] = 0;
        __syncthreads();
        { int tot[8], pre[8];
#pragma unroll
          for (int e = 0; e < 8; ++e) { tot[e] = 0; pre[e] = 0; }
          for (int ch = F.tid; ch < NCHUNK; ch += 512) { const int4 a = *(const int4*)(CNT + ch * 8), b = *(const int4*)(CNT + ch * 8 + 4); const int m = ch < cbase ? 1 : 0;
              tot[0] += a.x; tot[1] += a.y; tot[2] += a.z; tot[3] += a.w; tot[4] += b.x; tot[5] += b.y; tot[6] += b.z; tot[7] += b.w;
              pre[0] += m * a.x; pre[1] += m * a.y; pre[2] += m * a.z; pre[3] += m * a.w; pre[4] += m * b.x; pre[5] += m * b.y; pre[6] += m * b.z; pre[7] += m * b.w; }
#pragma unroll
          for (int e = 0; e < 8; ++e) { int v = tot[e], w = pre[e];
              v = wave_sum_i(v); w = wave_sum_i(w);
              if (F.lane == 0) { atomicAdd((int*)&LI[e], v); atomicAdd((int*)&LI[8 + e], w); } } }
        __syncthreads();
        if (F.tid == 0) { int s = 0; for (int e = 0; e < 8; ++e) { LI[16 + e] = s; s += (LI[e] + 255) & ~255; }
            if (F.vcu == 0 && pass == 0) { int np = 0; for (int e = 0; e < 8; ++e) { MINFO[e] = LI[16 + e]; const int pe = (LI[e] + 255) >> 8; for (int k = 0; k < pe; ++k) MINFO[16 + np + k] = e; np += pe; } MINFO[8] = np; } }
        __syncthreads();
        if (actc) {
            int wb = 0; if (F.lane < 8) {
#pragma unroll
                for (int w = 0; w < 7; ++w) wb += cw[w];
                wb += LI[8 + F.lane] + LI[16 + F.lane]; }
            int2* POS = (int2*)(ws + WS_POS);
            const int e0 = tk.x & 255, e1 = (tk.x >> 8) & 255, r0 = (tk.x >> 16) & 255, r1 = (tk.x >> 24) & 255;
            const int p0 = __shfl(wb, e0) + r0, p1 = __shfl(wb, e1) + r1;
            if (F.lane < 16) POS[chunk * 16 + F.lane] = make_int2(p0, p1);
            unsigned char* HS = ws + WS_HS;
#pragma unroll 1
            for (int t8 = 0; t8 < 16; t8 += 4) {
                int q0[4], q1[4]; float rs[4];
#pragma unroll
                for (int a = 0; a < 4; ++a) { const int tt = t8 + a, tok = chunk * 16 + tt; q0[a] = __builtin_amdgcn_readlane(p0, tt); q1[a] = __builtin_amdgcn_readlane(p1, tt); rs[a] = u2f((unsigned)__builtin_amdgcn_readlane((int)tk.w, tt)) * FS_A;
                    if (t8 != 0) { const u32x4* xr = (const u32x4*)(XB + (size_t)tok * DM) + 2 * F.lane; v[a][0] = xr[0]; v[a][1] = xr[1]; } }
#pragma unroll
                for (int a = 0; a < 4; ++a) { u32x4 w;
                    w.x = pack4_fp8((f32x4){bflo(v[a][0].x), bfhi(v[a][0].x), bflo(v[a][0].y), bfhi(v[a][0].y)} * rs[a]); w.y = pack4_fp8((f32x4){bflo(v[a][0].z), bfhi(v[a][0].z), bflo(v[a][0].w), bfhi(v[a][0].w)} * rs[a]);
                    w.z = pack4_fp8((f32x4){bflo(v[a][1].x), bfhi(v[a][1].x), bflo(v[a][1].y), bfhi(v[a][1].y)} * rs[a]); w.w = pack4_fp8((f32x4){bflo(v[a][1].z), bfhi(v[a][1].z), bflo(v[a][1].w), bfhi(v[a][1].w)} * rs[a]);
                    *((u32x4*)(HS + (size_t)q0[a] * DM) + F.lane) = w; *((u32x4*)(HS + (size_t)q1[a] * DM) + F.lane) = w; }
            }
        }
    }
}

__device__ __forceinline__ void p_final(Frame& F, const Args& A) {
    FRESH_IDS(F);
    unsigned char* ws = F.ws; const u32x4* TOK = (const u32x4*)(ws + WS_TOK); const int2* POS = (const int2*)(ws + WS_POS); const bf16* YS = (const bf16*)(ws + WS_YS); float* XF = A.out; const bf16* XB = (const bf16*)(ws + WS_XB); const float* gf = KIN(I_NFIN);
    const int gw = F.vcu * NWAVES + F.wave, NGW = F.G * NWAVES; const bf16* SL = (const bf16*)(ws + WS_SLAB);
    f32x4 gg4[4];
#pragma unroll
    for (int j = 0; j < 4; ++j) gg4[j] = *((const f32x4*)gf + 64 * j + F.lane);
    u32x4 tkn[2]; int2 psn[2];
#pragma unroll
    for (int a = 0; a < 2; ++a) { const int t = gw * 2 + a < M ? gw * 2 + a : 0; tkn[a] = TOK[t]; psn[a] = POS[t]; }
    for (int tok0 = gw * 2; tok0 < M; tok0 += NGW * 2) {
        u32x4 tk[2]; int2 ps[2]; u32x2 x[2][4]; u32x2 ya[2][4], yb[2][4];
#pragma unroll
        for (int a = 0; a < 2; ++a) { tk[a] = tkn[a]; ps[a] = psn[a]; const int t = tok0 + NGW * 2 + a < M ? tok0 + NGW * 2 + a : 0; tkn[a] = TOK[t]; psn[a] = POS[t]; }
#pragma unroll
        for (int a = 0; a < 2; ++a) { const u32x2* xr = (const u32x2*)(XB + (size_t)(tok0 + a) * DM) + F.lane;
            const int pa = ps[a].x < 65536 ? ps[a].x : 0, pb = ps[a].y < 65536 ? ps[a].y : 0;
            const u32x2* y0 = (const u32x2*)(YS + (size_t)pa * DM) + F.lane; const u32x2* y1 = (const u32x2*)(YS + (size_t)pb * DM) + F.lane;
#pragma unroll
            for (int j = 0; j < 4; ++j) { x[a][j] = xr[64 * j]; ya[a][j] = y0[64 * j]; yb[a][j] = y1[64 * j]; } }
#pragma unroll
        for (int a = 0; a < 2; ++a) { const int tok = tok0 + a; const float w0 = DBG_MOE * u2f(tk[a].y), w1 = DBG_MOE * u2f(tk[a].z);
            f32x4 v[4]; float ss = 0.f;
#pragma unroll
            for (int j = 0; j < 4; ++j) { f32x4 fa, fb;
                if (ps[a].x < 65536) fa = (f32x4){bflo(ya[a][j].x), bfhi(ya[a][j].x), bflo(ya[a][j].y), bfhi(ya[a][j].y)};
                else { fa = (f32x4){0.f, 0.f, 0.f, 0.f}; for (int k = 0; k < pg8::KSPLIT; ++k) { const u32x2 q = *((const u32x2*)(SL + ((size_t)k * 2048 + (ps[a].x - 65536)) * DM) + F.lane + 64 * j); fa += (f32x4){bflo(q.x), bfhi(q.x), bflo(q.y), bfhi(q.y)}; } }
                if (ps[a].y < 65536) fb = (f32x4){bflo(yb[a][j].x), bfhi(yb[a][j].x), bflo(yb[a][j].y), bfhi(yb[a][j].y)};
                else { fb = (f32x4){0.f, 0.f, 0.f, 0.f}; for (int k = 0; k < pg8::KSPLIT; ++k) { const u32x2 q = *((const u32x2*)(SL + ((size_t)k * 2048 + (ps[a].y - 65536)) * DM) + F.lane + 64 * j); fb += (f32x4){bflo(q.x), bfhi(q.x), bflo(q.y), bfhi(q.y)}; } }
                v[j] = (f32x4){bflo(x[a][j].x), bfhi(x[a][j].x), bflo(x[a][j].y), bfhi(x[a][j].y)} + w0 * fa + w1 * fb;
                ss += (v[j][0] * v[j][0] + v[j][1] * v[j][1]) + (v[j][2] * v[j][2] + v[j][3] * v[j][3]); }
            ss = wave_sum(ss); const float rs = rsqrtf(ss * (1.0f / DM) + EPS);
            f32x4* xo = (f32x4*)(XF + (size_t)tok * DM) + F.lane;
#pragma unroll
            for (int j = 0; j < 4; ++j) xo[64 * j] = v[j] * rs * gg4[j]; }
    }
}

constexpr int PH_PRO = 0, PH_WIN = 1, PH_S5 = 2, PH_GLU = 3, PH_WOUT = 4, PH_FGU = 5, PH_FDN = 6, PH_KVQ = 7, PH_UKVQ = 8, PH_ATT = 9, PH_WO = 10, PH_ROUTE = 11, PH_SCAT = 12,
              PH_MOE0 = 13, PH_FINAL = PH_MOE0 + 3, N_PHASES = PH_FINAL + 1;

__global__ void __launch_bounds__(NWAVES * 64, 2) yoco_fwd(Args args) {
    extern __shared__ __attribute__((aligned(16))) unsigned char lds[];
    Frame F; F.lds = (LAS unsigned char*)lds; F.tid = threadIdx.x; F.lane = F.tid & 63; F.wave = __builtin_amdgcn_readfirstlane(F.tid >> 6);
    F.G = gridDim.x; { const int bx = blockIdx.x; F.vcu = (F.G % 8 == 0) ? (bx % 8) * (F.G / 8) + bx / 8 : bx; }
    F.ws = args.ws; unsigned char* ws = args.ws;
    volatile LAS unsigned* MISC = (volatile LAS unsigned*)(F.lds + MISC_OFF);
    for (int u = F.tid; u < (LDS_BYTES - MISC_OFF) / 4; u += NWAVES * 64) ((LAS unsigned*)(F.lds + MISC_OFF))[u] = 0u;
    __syncthreads();
    const int lo = args.ph_lo, hi = args.ph_hi;
    XcdBarrier bar; bar.bar = (unsigned*)(ws + WS_CTL) + CW_BAR + args.breg * XCD_BAR_WORDS; bar.x = 0; bar.st = nullptr;
    if (hi - lo > 1 || args.probe == 13) bar = xcd_barrier_post((unsigned*)(ws + WS_CTL) + CW_BAR + args.breg * XCD_BAR_WORDS, MISC + 8);
#define IN(k) (lo <= (k) && (k) < hi)
#define SEAM(k) do { if (IN(k) && IN((k) + 1)) xcd_barrier(bar); } while (0)
    const int bx = (int)blockIdx.x;
    bf16* XB = (bf16*)(ws + WS_XB); float* ST = (float*)(ws + WS_ST);

    if (IN(PH_PRO)) { p0_prologue(F, args); __syncthreads(); } SEAM(PH_PRO);

    if (IN(PH_WIN)) {
        pg8::Gemm g{XB, (const bf16*)(ws + WS_WIN), DM, DM, DM, 0, 0}; pg8::Order2D S; S.init(M / 256, DM / 256, F.G, bx);
        pg8::EpiUin E{F.lds, (bf16*)(ws + WS_UG)}; pg8::gemm_phase<pg8::EpiUin, pg8::Order2D, false, 16>(F.lds, g, S, E, ST, 1.0f / DM); } SEAM(PH_WIN);

    if (IN(PH_S5)) {
#pragma unroll 1
        for (int item = F.vcu; item < SG * 4; item += F.G) {
            const int gq = item >> 2, pm = item & 3;
            { pg8::Gemm g{(const bf16*)(ws + WS_UG) + UC0, (const bf16*)(ws + WS_WEND), UGLD, UK, UK, (size_t)BC * UGLD * 2, (size_t)256 * UK * 2}; pg8::OrderPanel S{gq, pm, 1, 0};
              pg8::EpiEnd E{(float*)(ws + WS_E)}; pg8::gemm_phase<pg8::EpiEnd, pg8::OrderPanel, false, 0, true>(F.lds, g, S, E); }
            scan_panel(F, gq, pm);
            VM_WAIT(); __syncthreads();
            { pg8::Gemm g{(const bf16*)(ws + WS_UG), (const bf16*)(ws + WS_BT4), UGLD, UGLD, UGLD, (size_t)BC * UGLD * 2, (size_t)512 * UGLD * 2}; pg8::OrderPanel S{gq, pm, 2, 6};
              pg8::EpiS5Y E{(bf16*)(ws + WS_YB)}; pg8::gemm_phase(F.lds, g, S, E); }
        }
    } SEAM(PH_S5);

    if (IN(PH_GLU)) {
        pg8::Gemm g{(const bf16*)(ws + WS_YB), (const bf16*)(ws + WS_WGLU), DM, DM, DM, 0, 0}; pg8::Order2D S; S.init(M / 256, DM / 256, F.G, bx);
        pg8::EpiGlu E{(const bf16*)(ws + WS_YB), (bf16*)(ws + WS_ZB)}; pg8::gemm_phase(F.lds, g, S, E); } SEAM(PH_GLU);

    if (IN(PH_WOUT)) {
        pg8::Gemm g{(const bf16*)(ws + WS_ZB), (const bf16*)(ws + WS_WOUT), DM, DM, DM, 0, 0}; pg8::Order2D S; S.init(M / 256, DM / 256, F.G, bx);
        pg8::EpiResid<0> E{KIN(I_X), args.out, XB, ST, DBG_S5}; pg8::gemm_phase(F.lds, g, S, E); } SEAM(PH_WOUT);

    if (IN(PH_FGU)) {
        pg8::Gemm g{XB, (const bf16*)(ws + WS_WGU), DM, DM, DM, 0, 0}; pg8::Order2D S; S.init(M / 256, NGU / 256, F.G, bx);
        pg8::EpiSwigluF8R E{F.lds, ws + WS_HB, H8LD}; pg8::gemm_phase<pg8::EpiSwigluF8R, pg8::Order2D, false, 16>(F.lds, g, S, E, ST, 1.0f / DM);
        if (F.G == 256 && bx >= 128) { __syncthreads(); small_weights(F, SW_EARLY, SW_ALL, (bx - 128) * NWAVES + F.wave, 128 * NWAVES); late_tables(F, bx - 128, 128); }
        for (int e = F.vcu * 512 + F.tid; e < M * 8; e += F.G * 512) *(u32x4*)(ws + WS_HB + (size_t)(e >> 3) * H8LD + DFF + (e & 7) * 16) = (u32x4){0u, 0u, 0u, 0u}; } SEAM(PH_FGU);

    if (IN(PH_FDN)) {
        pg8::Gemm g{(const bf16*)(ws + WS_HB), (const bf16*)(ws + WS_WDOWN), H8LD / 2, H8LD / 2, H8LD / 2, 0, 0}; pg8::Order2D S; S.init(M / 256, DM / 256, F.G, bx);
        pg8::EpiResid<1> E{nullptr, args.out, XB, ST, DBG_FFN * (1.0f / (FS_H * FS_W))}; pg8::gemm_phase<pg8::EpiResid<1>, pg8::Order2D, true>(F.lds, g, S, E); } SEAM(PH_FDN);

    if (IN(PH_KVQ)) {
        pg8::Gemm g{XB, (const bf16*)(ws + WS_WKVQ), DM, DM, DM, 0, 0}; pg8::Order2D S; S.init(M / 256, 4, F.G, bx);
        pg8::EpiKvq E{F.lds, (bf16*)(ws + WS_CKV), (bf16*)(ws + WS_CQ), (bf16*)(ws + WS_KR), (float*)(ws + WS_STKV), (float*)(ws + WS_STQ), (const float*)(ws + WS_COS), (const float*)(ws + WS_SIN)};
        pg8::gemm_phase<pg8::EpiKvq, pg8::Order2D, false, 16>(F.lds, g, S, E, ST, 1.0f / DM); } SEAM(PH_KVQ);

    if (IN(PH_UKVQ)) {
        { pg8::Gemm g{(const bf16*)(ws + WS_CKV), (const bf16*)(ws + WS_WUKV), KVL, KVL, KVL, 0, 0}; pg8::Order2D S; S.init(M / 256, 8, F.G, bx);
          pg8::EpiUkv E{F.lds, (bf16*)(ws + WS_KN), (bf16*)(ws + WS_VB)}; pg8::gemm_phase<pg8::EpiUkv, pg8::Order2D, false, 4>(F.lds, g, S, E, (const float*)(ws + WS_STKV), 1.0f / KVL); }
        { pg8::Gemm g{(const bf16*)(ws + WS_CQ), (const bf16*)(ws + WS_WUQ), QL, QL, QL, 0, 0}; pg8::Order2D S; S.init(M / 256, 6, F.G, bx);
          pg8::EpiUq E{F.lds, (bf16*)(ws + WS_QN), (bf16*)(ws + WS_QR), (const float*)(ws + WS_COS), (const float*)(ws + WS_SIN)}; pg8::gemm_phase<pg8::EpiUq, pg8::Order2D, false, 8>(F.lds, g, S, E, (const float*)(ws + WS_STQ), 1.0f / QL); }
    } SEAM(PH_UKVQ);

    if (IN(PH_ATT)) {
        const bf16* QN = (const bf16*)(ws + WS_QN); const bf16* QR = (const bf16*)(ws + WS_QR); const bf16* KN = (const bf16*)(ws + WS_KN); const bf16* KR = (const bf16*)(ws + WS_KR); const bf16* VB = (const bf16*)(ws + WS_VB);
        const int NU = BATCH * NH * 16; bf16* Ob = (bf16*)(ws + (args.probe ? WS_ARENA : WS_QN));
        if (F.G == 256) {
            if ((F.vcu % 8) == 0) { moe_weight_convert(F, (unsigned char*)args.out, F.vcu / 8, 32); __syncthreads(); }
            unsigned* qhead = (unsigned*)(ws + WS_CTL) + 64 + 16 * args.breg;
            unsigned pend = 0u;
            if (F.tid == 0) MISC[12] = atomicAdd(qhead, 1u);
            __syncthreads();
            unsigned cur = MISC[12];
            while (cur < (unsigned)NU) {
                if (F.tid == 0) pend = atomicAdd(qhead, 1u);
                const int qb = 15 - (int)(cur >> 7), bh = (int)(cur & 127u);
                if (F.wave < 4) attn::attn_unit<0>(bh >> 4, bh & 15, qb, QN, QR, KN, KR, VB, Ob, F.lds); else attn::attn_unit<1>(bh >> 4, bh & 15, qb, QN, QR, KN, KR, VB, Ob, F.lds);
                if (F.tid == 0) MISC[12] = pend;
                __syncthreads();
                cur = MISC[12]; }
        } else {
            for (int pos = F.vcu; pos < NU; pos += F.G) { const int qb = 15 - (pos >> 7), bh = pos & 127;
                if (F.wave < 4) attn::attn_unit<0>(bh >> 4, bh & 15, qb, QN, QR, KN, KR, VB, Ob, F.lds); else attn::attn_unit<1>(bh >> 4, bh & 15, qb, QN, QR, KN, KR, VB, Ob, F.lds); }
            __syncthreads(); moe_weight_convert(F, (unsigned char*)args.out, F.vcu, F.G); }
    } SEAM(PH_ATT);

    if (IN(PH_WO)) {
        pg8::Gemm g{(const bf16*)(ws + WS_QN), (const bf16*)(ws + WS_WO), DM, DM, DM, 0, 0}; pg8::Order2D S; S.init(M / 256, DM / 256, F.G, bx);
        pg8::EpiResid<3> E{nullptr, args.out, XB, ST, DBG_ATT}; pg8::gemm_phase(F.lds, g, S, E); } SEAM(PH_WO);

    if (IN(PH_ROUTE)) { p14_router(F, args); } SEAM(PH_ROUTE);
    if (IN(PH_SCAT)) { p15_scatter(F, args); } SEAM(PH_SCAT);

    {
        const int* MINFO = (const int*)(ws + WS_MINFO);
        if (IN(PH_MOE0)) {
            const int np = MINFO[8];
            pg8::Gemm g{(const bf16*)(ws + WS_HS), (const bf16*)((unsigned char*)args.out + OUT_WMGU), DM / 2, DM / 2, DM / 2, 0, (size_t)NMGU * DM}; pg8::OrderMoe S; S.init(MINFO + 16, 0, np, NMGU / 256, F.G, F.vcu);
            pg8::EpiSwigluF8 E{ws + WS_ACT, MFF, 0, 1.0f / (FS_A * FS_W)}; pg8::gemm_phase<pg8::EpiSwigluF8, pg8::OrderMoe, true>(F.lds, g, S, E); }
        SEAM(PH_MOE0);
        if (IN(PH_MOE0 + 1)) {
            const int np = MINFO[8], p1 = np < SLICE_P ? np : SLICE_P;
            pg8::Gemm g{(const bf16*)(ws + WS_ACT), (const bf16*)((unsigned char*)args.out + OUT_WMDN), MFF / 2, MFF / 2, MFF / 2, 0, (size_t)DM * MFF}; pg8::OrderMoe S; S.init(MINFO + 16, 0, p1, DM / 256, F.G, F.vcu);
            pg8::EpiPlain E{(bf16*)(ws + (args.probe ? WS_SLAB : WS_YS)), DM, args.probe ? 4095 : 0x7fffffff, 1.0f / (FS_H * FS_W)}; pg8::gemm_phase<pg8::EpiPlain, pg8::OrderMoe, true>(F.lds, g, S, E); }
        if (IN(PH_MOE0 + 2)) {
            const int np = MINFO[8];
            pg8::Gemm g{(const bf16*)(ws + WS_ACT), (const bf16*)((unsigned char*)args.out + OUT_WMDN), MFF / 2, MFF / 2, MFF / 2 / pg8::KSPLIT, 0, (size_t)DM * MFF}; pg8::OrderMoeSplit S; S.init(MINFO + 16, SLICE_P, np, F.G, F.vcu);
            pg8::EpiSlab E{(bf16*)(ws + WS_SLAB), 1.0f / (FS_H * FS_W)}; pg8::gemm_phase<pg8::EpiSlab, pg8::OrderMoeSplit, true>(F.lds, g, S, E); }
        SEAM(PH_MOE0 + 2);
    }

    if (IN(PH_FINAL)) { p_final(F, args); }
#undef IN
#undef SEAM
}

extern "C" void kernel_launch(void* const* d_in, const int* in_sizes, int n_in, void* d_out, int out_size, void* d_ws, size_t ws_size, hipStream_t stream) {
    static int grid = 0;
    if (grid == 0) {
        if (n_in != 31 || in_sizes[0] != M * DM || out_size != M * DM || ws_size < WS_END) { fprintf(stderr, "kernel_launch: unexpected shapes (n_in %d, in0 %d, out %d, ws %zu)\n", n_in, n_in > 0 ? in_sizes[0] : -1, out_size, ws_size); grid = -1; return; }
        int dev = 0, cus = 0, per_cu = 0;
        if (hipGetDevice(&dev) != hipSuccess || hipDeviceGetAttribute(&cus, hipDeviceAttributeMultiprocessorCount, dev) != hipSuccess) { grid = -1; return; }
        if (hipFuncSetAttribute((const void*)yoco_fwd, hipFuncAttributeMaxDynamicSharedMemorySize, LDS_BYTES) != hipSuccess) { fprintf(stderr, "kernel_launch: hipFuncSetAttribute failed\n"); grid = -1; return; }
        if (hipOccupancyMaxActiveBlocksPerMultiprocessor(&per_cu, (const void*)yoco_fwd, NWAVES * 64, LDS_BYTES) != hipSuccess || per_cu < 1) { fprintf(stderr, "kernel_launch: occupancy query says %d\n", per_cu); }
        (void)hipGetLastError();
        grid = cus;
    }
    if (grid < 0) return;
    if (hipMemsetAsync((char*)d_ws + WS_CTL, 0, CTL_ZERO_BYTES, stream) != hipSuccess) return;
    Args a{};
    for (int i = 0; i < 31; ++i) a.in[i] = (const float*)d_in[i];
    a.out = (float*)d_out; a.ws = (unsigned char*)d_ws;
#if defined(PROBE_DUP)
    a.ph_lo = 0; a.ph_hi = PROBE_DUP; a.breg = 0; if (PROBE_DUP > 0) hipLaunchKernelGGL(yoco_fwd, dim3(grid), dim3(NWAVES * 64), LDS_BYTES, stream, a);
    a.ph_lo = PROBE_DUP; a.ph_hi = PROBE_DUP + 1; a.probe = PROBE_MODE; a.breg = 1; hipLaunchKernelGGL(yoco_fwd, dim3(grid), dim3(NWAVES * 64), LDS_BYTES, stream, a);
    a.ph_lo = PROBE_DUP; a.ph_hi = N_PHASES; a.probe = 0; a.breg = 2; hipLaunchKernelGGL(yoco_fwd, dim3(grid), dim3(NWAVES * 64), LDS_BYTES, stream, a);
#elif MK_ONE_LAUNCH
    a.ph_lo = 0; a.ph_hi = N_PHASES;
    hipLaunchKernelGGL(yoco_fwd, dim3(grid), dim3(NWAVES * 64), LDS_BYTES, stream, a);
#else
    for (int p = 0; p < N_PHASES; ++p) { a.ph_lo = p; a.ph_hi = p + 1; hipLaunchKernelGGL(yoco_fwd, dim3(grid), dim3(NWAVES * 64), LDS_BYTES, stream, a); }
#endif
}
```
